# Optimizing an MI355X kernel written in HIP

```python
import math
import jax, jax.numpy as jnp
from jax import lax
import numpy as np

D_MODEL = 4096
BATCH = 32
SEQ = 256
DEPTH = 2
DEC_BATCH = 4
DEC_SEQ = 1024
PAST_LEN = 256

GRID_W = 64
N_MIXERS = 2
N_RWKV_LAYERS = (DEPTH + 1) // 2
N_GDN_LAYERS = DEPTH // 2
RWKV_HEAD = 64
RWKV_HEADS = D_MODEL // RWKV_HEAD
RWKV_LORA_W = 128
RWKV_LORA_A = 128
RWKV_GN_EPS = 64e-5
GDN_HEAD_K = 128
GDN_HEAD_V = 128
GDN_HEADS = D_MODEL // GDN_HEAD_V
GDN_CONV = 3
GDN_CHUNK = 64
NORM_EPS = 1e-6
L2_EPS = 1e-6

kernel_name = 'hybrid_rwkv7_gdn_diffusion_step'


def rms_norm(x, w):
    xf = x.astype(jnp.float32)
    y = xf * lax.rsqrt(jnp.mean(xf * xf, axis=-1, keepdims=True) + NORM_EPS)
    return (y * w.astype(jnp.float32)).astype(x.dtype)


def l2_normalize(x):
    xf = x.astype(jnp.float32)
    return xf * lax.rsqrt(jnp.sum(xf * xf, axis=-1, keepdims=True) + L2_EPS)


def modulation(cond, w_ada, b_ada):
    m = jnp.matmul(jax.nn.silu(cond), w_ada) + b_ada
    shift, scale, gate = jnp.split(m[:, None, :], 3, axis=-1)
    return shift, scale, gate


def seq_shift(h):
    half = h.shape[-1] // 2
    prev = jnp.pad(h[:, :-1, :half], ((0, 0), (1, 0), (0, 0)))
    nxt = jnp.pad(h[:, 1:, half:], ((0, 0), (0, 1), (0, 0)))
    return jnp.concatenate([prev, nxt], axis=-1)


def grid_shift(h):
    B, T, D = h.shape
    rows = T // GRID_W
    g = h.reshape(B, rows, GRID_W, D)
    q = D // 4
    left = jnp.pad(g[:, :, :-1, :q], ((0, 0), (0, 0), (1, 0), (0, 0)))
    right = jnp.pad(g[:, :, 1:, q:2 * q], ((0, 0), (0, 0), (0, 1), (0, 0)))
    up = jnp.pad(g[:, :-1, :, 2 * q:3 * q], ((0, 0), (1, 0), (0, 0), (0, 0)))
    down = jnp.pad(g[:, 1:, :, 3 * q:], ((0, 0), (0, 1), (0, 0), (0, 0)))
    return jnp.concatenate([left, right, up, down], axis=-1).reshape(B, T, D)


def wkv7_scan(s_init, r, w, k, v, kk, b, reverse):
    def step(S, inp):
        r_t, w_t, k_t, v_t, kk_t, b_t = inp
        S = (S * w_t[:, :, None, :]
             - jnp.einsum('bhvk,bhk->bhv', S, kk_t)[..., None] * b_t[:, :, None, :]
             + v_t[..., None] * k_t[:, :, None, :])
        return S, jnp.einsum('bhvk,bhk->bhv', S, r_t)
    xs = tuple(jnp.swapaxes(t, 0, 1) for t in (r, w, k, v, kk, b))
    S, y = lax.scan(step, s_init, xs, reverse=reverse)
    return S, jnp.swapaxes(y, 0, 1)


def rwkv7_mix(h, h_shift, s0, mu, w_in, w0, w1, w2, a0, a1, a2, k_k, k_a, r_k, ln_w, ln_b, w_out):
    B, T, D = h.shape
    H, K = RWKV_HEADS, RWKV_HEAD
    f32 = jnp.float32
    heads = lambda t: t.astype(f32).reshape(t.shape[:-1] + (H, K))
    xx = h_shift - h
    x_rkvz = h[None] + xx[None] * mu[:4, None, None, :]
    r, k, v, z = jnp.einsum('pbtd,pde->pbte', x_rkvz, w_in)
    x_w = h + xx * mu[4]
    x_a = h + xx * mu[5]
    w_log = (w0[:, None, None, :] + jnp.einsum(
        'zbtl,zld->zbtd', jnp.tanh(jnp.einsum('btd,zdl->zbtl', x_w, w1)), w2)).astype(f32)
    decay = jnp.exp(-jnp.exp(-jax.nn.softplus(-w_log) - 0.5))
    iclr = jax.nn.sigmoid((a0[:, None, None, :] + jnp.einsum(
        'zbtl,zld->zbtd', jnp.einsum('btd,zdl->zbtl', x_a, a1), a2)).astype(f32))
    r_h, v_h, iclr_h, decay_h = heads(r), heads(v), heads(iclr), heads(decay)
    kk = l2_normalize(heads(k * k_k))
    k_dir = heads(k)[None] * (1.0 + (iclr_h - 1.0) * heads(k_a))
    b_dir = kk[None] * iclr_h
    s_f, y_f = wkv7_scan(s0[:, 0].astype(f32), r_h, decay_h[0], k_dir[0], v_h, kk, b_dir[0], False)
    s_b, y_b = wkv7_scan(s0[:, 1].astype(f32), r_h, decay_h[1], k_dir[1], v_h, kk, b_dir[1], True)
    y = y_f + y_b
    mean = jnp.mean(y, axis=-1, keepdims=True)
    var = jnp.mean(jnp.square(y - mean), axis=-1, keepdims=True)
    y = ((y - mean) * lax.rsqrt(var + RWKV_GN_EPS)).reshape(B, T, D) * ln_w.astype(f32) + ln_b.astype(f32)
    bonus = jnp.einsum('bthk,zbthk,zhk->bth', r_h, k_dir, r_k.astype(f32))
    y = y + (bonus[..., None] * v_h).reshape(B, T, D)
    out = jnp.matmul((y * jax.nn.silu(z.astype(f32))).astype(h.dtype), w_out)
    return out, s_f, s_b


def chunk_gated_delta(q, k, v, g, beta, s_init):
    B, T, H, DK = q.shape
    DV = v.shape[-1]
    C = GDN_CHUNK
    N = T // C

    def chunks(t):
        t = t.reshape((B, N, C, H) + t.shape[3:])
        return jnp.swapaxes(jnp.swapaxes(t, 0, 1), 2, 3)

    q, k, v, g, beta = (chunks(t) for t in (q, k, v, g, beta))
    gc = jnp.cumsum(g, axis=-1)
    tril = jnp.tril(jnp.ones((C, C), bool))
    strict = jnp.tril(jnp.ones((C, C), bool), -1)
    diff = gc[..., :, None] - gc[..., None, :]
    decay = jnp.where(tril, jnp.exp(jnp.where(tril, diff, 0.0)), 0.0)
    k_beta = k * beta[..., None]
    L = jnp.where(strict, jnp.einsum('nbhik,nbhjk->nbhij', k_beta, k) * decay, 0.0)
    eye = jnp.eye(C, dtype=jnp.float32)
    rhs = jnp.concatenate([v * beta[..., None], k_beta * jnp.exp(gc)[..., None]], axis=-1)
    sol = lax.linalg.triangular_solve(eye + L, rhs, left_side=True, lower=True, unit_diagonal=True)
    u, w = sol[..., :DV], sol[..., DV:]
    qk = jnp.where(tril, jnp.einsum('nbhik,nbhjk->nbhij', q, k) * decay, 0.0)

    def step(S, inp):
        q_c, k_c, u_c, w_c, qk_c, gc_c = inp
        v_new = u_c - jnp.einsum('bhck,bhkv->bhcv', w_c, S)
        o = (jnp.einsum('bhck,bhkv->bhcv', q_c * jnp.exp(gc_c)[..., None], S)
             + jnp.einsum('bhij,bhjv->bhiv', qk_c, v_new))
        g_last = gc_c[..., -1:]
        S = (S * jnp.exp(g_last)[..., None]
             + jnp.einsum('bhck,bhcv->bhkv', k_c * jnp.exp(g_last - gc_c)[..., None], v_new))
        return S, o

    S, o = lax.scan(step, s_init, (q, k, u, w, qk, gc))
    o = jnp.swapaxes(jnp.swapaxes(o, 2, 3), 0, 1).reshape(B, T, H, DV)
    return S, o


def centred_conv(x, w):
    pad = GDN_CONV // 2
    T = x.shape[1]
    xp = jnp.pad(x, ((0, 0), (pad, pad), (0, 0)))
    return sum(xp[:, j:j + T] * w[j] for j in range(GDN_CONV))


def gdn_mix(h, s0, w_in, conv_w, w_ab, A_log, dt_bias, norm_w, w_out):
    B, T, D = h.shape
    H, DK, DV = GDN_HEADS, GDN_HEAD_K, GDN_HEAD_V
    f32 = jnp.float32
    qkvz = jnp.matmul(h, w_in)
    n_qkv = 2 * H * DK + H * DV
    qkv = jax.nn.silu(centred_conv(qkvz[..., :n_qkv], conv_w))
    z = qkvz[..., n_qkv:]
    q = l2_normalize(qkv[..., :H * DK].reshape(B, T, H, DK)) * (DK ** -0.5)
    k = l2_normalize(qkv[..., H * DK:2 * H * DK].reshape(B, T, H, DK))
    v = qkv[..., 2 * H * DK:].astype(f32).reshape(B, T, H, DV)
    ab = jnp.matmul(h, w_ab).astype(f32).reshape(B, T, 2, 2, H)
    g = -jnp.exp(A_log.astype(f32)) * jax.nn.softplus(ab[:, :, :, 0] + dt_bias.astype(f32))
    beta = jax.nn.sigmoid(ab[:, :, :, 1])
    s_f, o_f = chunk_gated_delta(q, k, v, g[:, :, 0], beta[:, :, 0], s0[:, 0].astype(f32))
    rev = lambda t: jnp.flip(t, axis=1)
    s_b, o_b = chunk_gated_delta(rev(q), rev(k), rev(v), rev(g[:, :, 1]), rev(beta[:, :, 1]),
                                 s0[:, 1].astype(f32))
    o = o_f + rev(o_b)
    o = o * lax.rsqrt(jnp.mean(o * o, axis=-1, keepdims=True) + NORM_EPS) * norm_w.astype(f32)
    o = o.reshape(B, T, H * DV) * jax.nn.silu(z.astype(f32))
    return jnp.matmul(o.astype(h.dtype), w_out), s_f, s_b


def setup_inputs(seed: int = 0) -> dict:
    key = jax.random.key(seed)
    ks = iter(jax.random.split(key, 48))

    def nrm(shape, scale):
        return jax.random.normal(next(ks), shape, jnp.float32) * scale

    def unif(shape, lo, hi):
        return jax.random.uniform(next(ks), shape, jnp.float32, lo, hi)

    D = D_MODEL
    NA, NB = N_RWKV_LAYERS, N_GDN_LAYERS
    Hr, Kr = RWKV_HEADS, RWKV_HEAD
    Hg, DK, DV = GDN_HEADS, GDN_HEAD_K, GDN_HEAD_V
    s_in = D ** -0.5
    decay_speed = -6.5 + 5.0 * (jnp.arange(D, dtype=jnp.float32) / (D - 1)) ** 0.85
    dt = jnp.exp(unif((NB, 2, Hg), math.log(1e-3), math.log(1e-1)))
    dt_bias = dt + jnp.log(-jnp.expm1(-dt))
    a_log = jnp.log(unif((NB, 2, Hg), 1.0, 16.0))
    return {
        'x_prompt': nrm((BATCH, SEQ, D), 1.0),
        'x_sample': nrm((DEC_BATCH, DEC_SEQ, D), 1.0),
        'state_rwkv': nrm((DEC_BATCH, NA, 2, Hr, Kr, Kr), 0.5),
        'state_gdn': nrm((DEC_BATCH, NB, 2, Hg, DK, DV), 0.3),
        'c': nrm((DEC_BATCH, D), 1.0),
        'c_ctx': nrm((D,), 1.0),
        'ada_w': nrm((DEPTH, D, 3 * D), 0.5 * s_in),
        'ada_b': nrm((DEPTH, 3 * D), 0.02),
        'norm_w': 1.0 + nrm((DEPTH, D), 0.05),
        'final_norm_w': 1.0 + nrm((D,), 0.05),
        'rwkv_mu': unif((NA, 6, D), 0.0, 1.0),
        'rwkv_w_in': nrm((NA, 4, D, D), s_in),
        'rwkv_w0': decay_speed + nrm((NA, 2, D), 0.1),
        'rwkv_w1': nrm((NA, 2, D, RWKV_LORA_W), s_in),
        'rwkv_w2': nrm((NA, 2, RWKV_LORA_W, D), 0.1 * RWKV_LORA_W ** -0.5),
        'rwkv_a0': nrm((NA, 2, D), 0.1),
        'rwkv_a1': nrm((NA, 2, D, RWKV_LORA_A), s_in),
        'rwkv_a2': nrm((NA, 2, RWKV_LORA_A, D), 0.1 * RWKV_LORA_A ** -0.5),
        'rwkv_k_k': 0.85 + nrm((NA, D), 0.02),
        'rwkv_k_a': 1.0 + nrm((NA, D), 0.02),
        'rwkv_r_k': nrm((NA, 2, Hr, Kr), 0.1),
        'rwkv_ln_w': 1.0 + nrm((NA, D), 0.05),
        'rwkv_ln_b': nrm((NA, D), 0.02),
        'rwkv_w_out': nrm((NA, D, D), s_in),
        'gdn_w_in': nrm((NB, D, 2 * Hg * DK + 2 * Hg * DV), s_in),
        'gdn_conv': nrm((NB, GDN_CONV, 2 * Hg * DK + Hg * DV), 0.5),
        'gdn_w_ab': nrm((NB, D, 4 * Hg), s_in),
        'gdn_A_log': a_log,
        'gdn_dt_bias': dt_bias,
        'gdn_norm_w': 1.0 + nrm((NB, DV), 0.05),
        'gdn_w_out': nrm((NB, Hg * DV, D), s_in),
    }


def reference(x_prompt, x_sample, state_rwkv, state_gdn, c, c_ctx, ada_w, ada_b, norm_w, final_norm_w,
              rwkv_mu, rwkv_w_in, rwkv_w0, rwkv_w1, rwkv_w2, rwkv_a0, rwkv_a1, rwkv_a2, rwkv_k_k, rwkv_k_a,
              rwkv_r_k, rwkv_ln_w, rwkv_ln_b, rwkv_w_out,
              gdn_w_in, gdn_conv, gdn_w_ab, gdn_A_log, gdn_dt_bias, gdn_norm_w, gdn_w_out):
    n_ctx = x_prompt.shape[0]
    xp, xs = x_prompt, x_sample
    new_rwkv, new_gdn = [], []
    for i in range(DEPTH):
        j = i // N_MIXERS
        sh_p, sc_p, gt_p = modulation(c_ctx[None, :], ada_w[i], ada_b[i])
        sh_s, sc_s, gt_s = modulation(c, ada_w[i], ada_b[i])
        hp = rms_norm(xp, norm_w[i]) * (1.0 + sc_p) + sh_p
        hs = rms_norm(xs, norm_w[i]) * (1.0 + sc_s) + sh_s
        if i % N_MIXERS == 0:
            p = (rwkv_mu[j], rwkv_w_in[j], rwkv_w0[j], rwkv_w1[j], rwkv_w2[j], rwkv_a0[j], rwkv_a1[j],
                 rwkv_a2[j], rwkv_k_k[j], rwkv_k_a[j], rwkv_r_k[j], rwkv_ln_w[j], rwkv_ln_b[j], rwkv_w_out[j])
            s_zero = jnp.zeros((n_ctx, 2, RWKV_HEADS, RWKV_HEAD, RWKV_HEAD), jnp.float32)
            out_p, s_f, s_b = rwkv7_mix(hp, seq_shift(hp), s_zero, *p)
            out_s, _, _ = rwkv7_mix(hs, grid_shift(hs), state_rwkv[:, j], *p)
            new_rwkv.append(jnp.stack([s_f, s_b], axis=1))
        else:
            p = (gdn_w_in[j], gdn_conv[j], gdn_w_ab[j], gdn_A_log[j], gdn_dt_bias[j], gdn_norm_w[j], gdn_w_out[j])
            s_zero = jnp.zeros((n_ctx, 2, GDN_HEADS, GDN_HEAD_K, GDN_HEAD_V), jnp.float32)
            out_p, s_f, s_b = gdn_mix(hp, s_zero, *p)
            out_s, _, _ = gdn_mix(hs, state_gdn[:, j], *p)
            new_gdn.append(jnp.stack([s_f, s_b], axis=1))
        xp = xp + gt_p * out_p
        xs = xs + gt_s * out_s
    y_prompt = rms_norm(xp, final_norm_w)
    y_sample = rms_norm(xs, final_norm_w)
    new_state_rwkv = jnp.stack(new_rwkv, axis=1)
    new_state_gdn = jnp.stack(new_gdn, axis=1)
    return (y_prompt, y_sample, new_state_rwkv, new_state_gdn)
```

```cpp
#include <hip/hip_runtime.h>
#include <cstdio>
#include <cstdint>
namespace pg8 {
#define PG8_LAS __attribute__((address_space(3)))
typedef unsigned short bf16_t;
typedef short bf16x8 __attribute__((ext_vector_type(8)));
typedef float f32x4 __attribute__((ext_vector_type(4)));
typedef unsigned u32x4 __attribute__((ext_vector_type(4)));
constexpr int BM = 256, BK = 64, HALF = 128, HTB = HALF * BK * 2  , STAGE_BYTES = 8 * HTB, NXCD = 8, WGM = 8;

__host__ __device__ __forceinline__ int lds_byte(int r, int c) { const int st = (r >> 4) * 2 + (c >> 5), rr = r & 15, cc = c & 31, ob = rr * 64 + cc * 2; return st * 1024 + (ob ^ (((ob >> 9) & 1) << 5)); }
__host__ __device__ __forceinline__ void stage_rc(int b, int& R, int& C) { const int st = b / 1024, sb = b % 1024, swz = sb ^ (((sb >> 9) & 1) << 5); R = (st >> 1) * 16 + swz / 64; C = (st & 1) * 32 + (swz % 64) / 2; }
__host__ __device__ __forceinline__ int perm32(int rho) { const int n = rho >> 4, i = rho & 15; return 8 * (i >> 2) + 4 * n + (i & 3); }

struct Unit { int pm, pn, k0, nt; };
struct Gemm { const bf16_t* A; const bf16_t* Bt; int M, N, K; };

__device__ __forceinline__ unsigned cvt_pk_bf16(float lo, float hi) { unsigned r; asm volatile("v_cvt_pk_bf16_f32 %0, %1, %2" : "=v"(r) : "v"(lo), "v"(hi)); return r; }

template <class Epi, class Sched, bool ALIGN_EPI = false, bool SP2 = false>
__device__ __forceinline__ void gemm_phase(PG8_LAS unsigned char* lds, const Gemm g, const Sched& S, const Epi& E) {
    const int tid = threadIdx.x, wid = __builtin_amdgcn_readfirstlane(tid >> 6), lane = tid & 63, wr = wid >> 2, wc = wid & 3, fr = lane & 15, fq = lane >> 4;
    const int K = g.K;
    unsigned voffA[2], voffB[2];
#pragma unroll
    for (int i = 0; i < 2; ++i) { int R, C; stage_rc(tid * 16 + i * 8192, R, C); const int Rb = Epi::PERM ? ((R & ~31) + perm32(R & 31)) : R;
        voffA[i] = (unsigned)(R * K + C) * 2u; voffB[i] = (unsigned)(Rb * K + C) * 2u; }
    const size_t kstep = (size_t)(BK * 2);
    const size_t hstep = (size_t)HALF * K * 2;
    const size_t tstep = 2 * hstep;
    const unsigned ldsw = (unsigned)wid * 1024u;
    const int aoff = lds_byte(wr * 64 + fr, fq * 8), boff = lds_byte(wc * 32 + fr, fq * 8);
#define PG8_SA(b, h) (((b) * 2 + (h)) * HTB)
#define PG8_SB(b, h) ((4 + (b) * 2 + (h)) * HTB)
#define PG8_STAGE(bufoff, gbase, voff) do { _Pragma("unroll") for (int _i = 0; _i < 2; ++_i) \
        __builtin_amdgcn_global_load_lds((const unsigned*)((const char*)(gbase) + (voff)[_i]), (PG8_LAS unsigned*)(lds + (bufoff) + ldsw + _i * 8192), 16, 0, 0); } while (0)
#define PG8_LDA(dst, b, h) do { _Pragma("unroll") for (int m = 0; m < 4; ++m) _Pragma("unroll") for (int k = 0; k < 2; ++k) dst[m][k] = *(const PG8_LAS bf16x8*)(lds + PG8_SA(b, h) + aoff + m * 2048 + k * 1024); } while (0)
#define PG8_LDB(dst, b, h) do { _Pragma("unroll") for (int n = 0; n < 2; ++n) _Pragma("unroll") for (int k = 0; k < 2; ++k) dst[n][k] = *(const PG8_LAS bf16x8*)(lds + PG8_SB(b, h) + boff + n * 2048 + k * 1024); } while (0)
#define PG8_MMA(ai, bj, At, Bt) do { __builtin_amdgcn_s_setprio(1); _Pragma("unroll") for (int m = 0; m < 4; ++m) _Pragma("unroll") for (int n = 0; n < 2; ++n) _Pragma("unroll") for (int k = 0; k < 2; ++k) \
        acc[ai][bj][m][n] = __builtin_amdgcn_mfma_f32_16x16x32_bf16(Bt[n][k], At[m][k], acc[ai][bj][m][n], 0, 0, 0); __builtin_amdgcn_s_setprio(0); } while (0)
#define PG8_WAIT_V(n) asm volatile("s_waitcnt vmcnt(" #n ")" ::: "memory")
#define PG8_WAIT_L(n) asm volatile("s_waitcnt lgkmcnt(" #n ")" ::: "memory")
#define PG8_BAR __builtin_amdgcn_s_barrier()
#define PG8_SCHED __builtin_amdgcn_sched_barrier(0)
    Unit cur, nxt; int ui = 0;
    if (!S.next(0, cur)) return;
    f32x4 acc[2][2][4][2];
#pragma unroll
    for (int a = 0; a < 2; ++a)
#pragma unroll
        for (int b = 0; b < 2; ++b)
#pragma unroll
            for (int m = 0; m < 4; ++m)
#pragma unroll
                for (int n = 0; n < 2; ++n) acc[a][b][m][n] = (f32x4){0.f, 0.f, 0.f, 0.f};
    bf16x8 At[4][2], B0[2][2], B1[2][2];
    const char* cA = (const char*)g.A + (size_t)cur.pm * tstep + (size_t)cur.k0 * 2; const char* cB = (const char*)g.Bt + (size_t)cur.pn * tstep + (size_t)cur.k0 * 2;
    S.a_ready(cur);
    if constexpr (SP2) {
        PG8_STAGE(PG8_SB(0, 0), cB, voffB); PG8_STAGE(PG8_SB(0, 1), cB + hstep, voffB); PG8_STAGE(PG8_SA(0, 0), cA, voffA); PG8_STAGE(PG8_SA(0, 1), cA + hstep, voffA);
        if (wr == 1) PG8_BAR;
        PG8_WAIT_V(2); PG8_BAR;
        PG8_STAGE(PG8_SB(1, 0), cB + kstep, voffB); PG8_STAGE(PG8_SA(1, 0), cA + kstep, voffA); PG8_STAGE(PG8_SB(1, 1), cB + hstep + kstep, voffB);
        PG8_WAIT_V(6); PG8_BAR;
    } else {
        PG8_STAGE(PG8_SB(0, 0), cB, voffB); PG8_STAGE(PG8_SA(0, 0), cA, voffA); PG8_STAGE(PG8_SB(0, 1), cB + hstep, voffB); PG8_STAGE(PG8_SA(0, 1), cA + hstep, voffA);
        if (wr == 1) PG8_BAR;
        PG8_WAIT_V(4); PG8_BAR;
        PG8_STAGE(PG8_SB(1, 0), cB + kstep, voffB); PG8_STAGE(PG8_SA(1, 0), cA + kstep, voffA); PG8_STAGE(PG8_SB(1, 1), cB + hstep + kstep, voffB);
        PG8_WAIT_V(6); PG8_BAR;
    }
    for (;;) {
        const bool has_next = S.next(ui + 1, nxt);
        const char* nA = has_next ? (const char*)g.A + (size_t)nxt.pm * tstep + (size_t)nxt.k0 * 2 : cA; const char* nB = has_next ? (const char*)g.Bt + (size_t)nxt.pn * tstep + (size_t)nxt.k0 * 2 : cB;
        const int nt = cur.nt;
#define PG8_WAIT_VP() do { if (peel) asm volatile("s_waitcnt vmcnt(%0)" :: "n"(8 + Epi::MIN_VMEM) : "memory"); else PG8_WAIT_V(8); } while (0)
        if constexpr (SP2) {
        for (int t = 0; t < nt; t += 2) {
            int peel = __builtin_amdgcn_readfirstlane((ALIGN_EPI && t == 0 && ui > 0) ? 1 : 0); asm volatile("" : "+s"(peel));
            const bool last = (t == nt - 2);
            const char* a1 = cA + (size_t)(t + 1) * kstep;
            const char* a2 = last ? nA : cA + (size_t)(t + 2) * kstep; const char* b2 = last ? nB : cB + (size_t)(t + 2) * kstep;
            const char* a3 = a2 + kstep; const char* b3 = b2 + kstep;
            if (last && has_next) S.a_ready(nxt);
            PG8_LDB(B0, 0, 0); PG8_LDB(B1, 0, 1); PG8_SCHED; PG8_LDA(At, 0, 0); if (!peel) PG8_STAGE(PG8_SA(1, 1), a1 + hstep, voffA);
            PG8_WAIT_VP(); PG8_WAIT_L(0); PG8_BAR; PG8_MMA(0, 0, At, B0); PG8_MMA(0, 1, At, B1); PG8_BAR; PG8_SCHED;
            PG8_LDA(At, 0, 1); PG8_STAGE(PG8_SB(0, 0), b2, voffB); PG8_STAGE(PG8_SB(0, 1), b2 + hstep, voffB); PG8_STAGE(PG8_SA(0, 0), a2, voffA);
            PG8_WAIT_VP(); PG8_WAIT_L(0); PG8_BAR; PG8_MMA(1, 0, At, B0); PG8_MMA(1, 1, At, B1); PG8_BAR; PG8_SCHED;
            PG8_LDB(B0, 1, 0); PG8_LDB(B1, 1, 1); PG8_SCHED; PG8_LDA(At, 1, 0); PG8_STAGE(PG8_SA(0, 1), a2 + hstep, voffA);
            PG8_WAIT_VP(); PG8_WAIT_L(0); PG8_BAR; PG8_MMA(0, 0, At, B0); PG8_MMA(0, 1, At, B1); PG8_BAR; PG8_SCHED;
            PG8_LDA(At, 1, 1); PG8_STAGE(PG8_SB(1, 0), b3, voffB); PG8_STAGE(PG8_SB(1, 1), b3 + hstep, voffB); PG8_STAGE(PG8_SA(1, 0), a3, voffA);
            PG8_WAIT_V(8); PG8_WAIT_L(0); PG8_BAR; PG8_MMA(1, 0, At, B0); PG8_MMA(1, 1, At, B1); PG8_BAR; PG8_SCHED;
        }
        } else {
        for (int t = 0; t < nt; t += 2) {
            const bool last = (t == nt - 2);
            const char* a1 = cA + (size_t)(t + 1) * kstep;
            const char* a2 = last ? nA : cA + (size_t)(t + 2) * kstep; const char* b2 = last ? nB : cB + (size_t)(t + 2) * kstep;
            const char* a3 = a2 + kstep; const char* b3 = b2 + kstep;
            if (last && has_next) S.a_ready(nxt);
            PG8_LDB(B0, 0, 0); PG8_SCHED; PG8_LDA(At, 0, 0); PG8_STAGE(PG8_SA(1, 1), a1 + hstep, voffA);
            PG8_WAIT_L(8); PG8_BAR; PG8_WAIT_L(0); PG8_MMA(0, 0, At, B0); PG8_BAR; PG8_SCHED;
            PG8_LDB(B1, 0, 1); PG8_STAGE(PG8_SB(0, 0), b2, voffB);
            PG8_BAR; PG8_WAIT_L(0); PG8_MMA(0, 1, At, B1); PG8_BAR;
            PG8_LDA(At, 0, 1); PG8_STAGE(PG8_SA(0, 0), a2, voffA);
            PG8_BAR; PG8_WAIT_L(0); PG8_MMA(1, 0, At, B0); PG8_BAR; PG8_SCHED;
            PG8_STAGE(PG8_SB(0, 1), b2 + hstep, voffB);
            PG8_WAIT_V(6); PG8_BAR; PG8_MMA(1, 1, At, B1); PG8_BAR;
            PG8_LDB(B0, 1, 0); PG8_SCHED; PG8_LDA(At, 1, 0); PG8_STAGE(PG8_SA(0, 1), a2 + hstep, voffA);
            PG8_WAIT_L(8); PG8_BAR; PG8_WAIT_L(0); PG8_MMA(0, 0, At, B0); PG8_BAR; PG8_SCHED;
            PG8_LDB(B1, 1, 1); PG8_STAGE(PG8_SB(1, 0), b3, voffB);
            PG8_BAR; PG8_WAIT_L(0); PG8_MMA(0, 1, At, B1); PG8_BAR;
            PG8_LDA(At, 1, 1); PG8_STAGE(PG8_SA(1, 0), a3, voffA);
            PG8_BAR; PG8_WAIT_L(0); PG8_MMA(1, 0, At, B0); PG8_BAR; PG8_SCHED;
            PG8_STAGE(PG8_SB(1, 1), b3 + hstep, voffB);
            PG8_WAIT_V(6); PG8_BAR; PG8_MMA(1, 1, At, B1); PG8_BAR;
        }
        }
#undef PG8_WAIT_VP
        if constexpr (ALIGN_EPI) { if (wr == 0) PG8_BAR; }
        if constexpr (SP2 && ALIGN_EPI) { PG8_STAGE(PG8_SA(1, 1), nA + kstep + hstep, voffA); PG8_SCHED; }
        if constexpr (!Epi::AFTER_DRAIN) { E(acc, cur, wr, wc, fr, fq); S.done(cur); }
        if (!has_next) break;
#pragma unroll
        for (int a = 0; a < 2; ++a)
#pragma unroll
            for (int b = 0; b < 2; ++b)
#pragma unroll
                for (int m = 0; m < 4; ++m)
#pragma unroll
                    for (int n = 0; n < 2; ++n) acc[a][b][m][n] = (f32x4){0.f, 0.f, 0.f, 0.f};
        cur = nxt; cA = nA; cB = nB; ++ui;
        if constexpr (ALIGN_EPI) { if (wr == 1) PG8_BAR; }
    }
    PG8_WAIT_V(0);
    if constexpr (!ALIGN_EPI) { if (wr == 0) PG8_BAR; }
    PG8_BAR;
    if constexpr (Epi::AFTER_DRAIN) { E.fused(acc, cur, wr, wc, fr, fq, lds, wid, lane); S.done(cur); }
#undef PG8_SA
#undef PG8_SB
#undef PG8_STAGE
#undef PG8_LDA
#undef PG8_LDB
#undef PG8_MMA
#undef PG8_WAIT_V
#undef PG8_WAIT_L
#undef PG8_BAR
#undef PG8_SCHED
}
}

#ifndef MK_ONE_LAUNCH
#define MK_ONE_LAUNCH 1
#endif
constexpr int NWAVES = 8;
constexpr int D = 4096, MC = 8192, MLAT = 4096, M = MC + MLAT, NPAN = M / 256;
constexpr int NPH = 14;
constexpr size_t MiB = 1u << 20;
constexpr size_t WS_CTL = 0, CTL_ZERO_BYTES = 64 * 1024;
constexpr size_t WS_MOD = 1 * MiB;
constexpr size_t WS_RSTD = 2 * MiB;
constexpr size_t WS_GB = 3 * MiB;
constexpr size_t WS_WUP = 10 * MiB;
constexpr size_t WS_WIN = 16 * MiB;
constexpr size_t WS_WOUT = 148 * MiB;
constexpr size_t WS_A = 180 * MiB;
constexpr size_t WS_B = 756 * MiB;
constexpr size_t WS_C = 1140 * MiB;
constexpr size_t WS_END = 1524 * MiB;
constexpr size_t O_Y = 0, O_RS = (size_t)M * D, O_GS = O_RS + (size_t)32 * 2 * 64 * 64 * 64, O_END = O_GS + (size_t)32 * 2 * 32 * 128 * 128;
constexpr size_t GS_G = 0;
constexpr size_t GS_MID = 96 * MiB;
constexpr size_t GS_AB = 108 * MiB;
constexpr int CW_BAR = 4096;

constexpr int RING_BYTES = 143360, LDSCTL_OFF = RING_BYTES, MISC_OFF = LDSCTL_OFF + 320, LDS_BYTES = 147456;

#define GAS __attribute__((address_space(1)))
#define LAS __attribute__((address_space(3)))
typedef unsigned short bf16;
typedef unsigned v4u __attribute__((ext_vector_type(4)));
typedef unsigned v2u __attribute__((ext_vector_type(2)));
typedef float f32x4 __attribute__((ext_vector_type(4)));
typedef GAS unsigned gu32;
#define RLX_AGENT __ATOMIC_RELAXED, __HIP_MEMORY_SCOPE_AGENT
#define LDS_WAIT() asm volatile("s_waitcnt lgkmcnt(0)" ::: "memory")
#define VM_WAIT() asm volatile("s_waitcnt vmcnt(0)" ::: "memory")
__device__ __forceinline__ unsigned f2bf(float f) { unsigned u = __builtin_bit_cast(unsigned, f); return (u + 0x7fffu + ((u >> 16) & 1u)) >> 16; }
typedef float f32x2_t __attribute__((ext_vector_type(2))); typedef __bf16 bf16x2_t __attribute__((ext_vector_type(2)));
__device__ __forceinline__ unsigned cvtpk(float lo, float hi) { f32x2_t v = {lo, hi}; bf16x2_t b = __builtin_convertvector(v, bf16x2_t); return __builtin_bit_cast(unsigned, b); }
__device__ __forceinline__ unsigned pk2(float lo, float hi) { return cvtpk(lo, hi); }
__device__ __forceinline__ float bf2f(unsigned short b) { return __builtin_bit_cast(float, (unsigned)b << 16); }
__device__ __forceinline__ f32x4 bf4(v2u w) { f32x4 r; r.x = __builtin_bit_cast(float, w.x << 16); r.y = __builtin_bit_cast(float, w.x & 0xffff0000u); r.z = __builtin_bit_cast(float, w.y << 16); r.w = __builtin_bit_cast(float, w.y & 0xffff0000u); return r; }
__device__ __forceinline__ v2u pk4(f32x4 v) { v2u r; r.x = pk2(v.x, v.y); r.y = pk2(v.z, v.w); return r; }
__device__ __forceinline__ float sigmoidf_(float x) { return __builtin_amdgcn_rcpf(1.f + __expf(-x)); }
__device__ __forceinline__ float siluf_(float x) { return x * __builtin_amdgcn_rcpf(1.f + __expf(-x)); }
__device__ __forceinline__ float softplusf_(float x) { return fmaxf(x, 0.f) + log1pf(__expf(-fabsf(x))); }
__device__ __forceinline__ f32x4 silu4(f32x4 v) { f32x4 r; r.x = siluf_(v.x); r.y = siluf_(v.y); r.z = siluf_(v.z); r.w = siluf_(v.w); return r; }
#define XB_TMO      128
#define XB_XCNT(j)  (256  + 64 * (j))
#define XB_XSUB(j)  (1280 + 64 * (j))
#define XB_XGEN(j)  (2304 + 64 * (j))
#define XB_TOP      3328
#define XB_TOPGEN   3392
#define XCD_BAR_WORDS 3456
#define XB_SPIN_CAP (1u << 18)

__device__ __forceinline__ unsigned xb_ld(unsigned* p)              { return __hip_atomic_load(p, __ATOMIC_RELAXED, __HIP_MEMORY_SCOPE_AGENT); }
__device__ __forceinline__ unsigned xb_add(unsigned* p, unsigned v) { return __hip_atomic_fetch_add(p, v, __ATOMIC_RELAXED, __HIP_MEMORY_SCOPE_AGENT); }
__device__ __forceinline__ unsigned xb_xcc_id() { return (unsigned)__builtin_amdgcn_s_getreg((3 << 11) | 20) & 0xFu; }
#define XB_SPIN(cond, bar) do { unsigned _sp = 0; while (cond) { __builtin_amdgcn_s_sleep(1); \
    if ((++_sp & 255u) == 0u) { if (xb_ld(&(bar)[XB_TMO])) break; if (_sp > XB_SPIN_CAP) { atomicAdd(&(bar)[XB_TMO], 1u); break; } } } } while (0)

struct XcdBarrier {
    unsigned* bar; unsigned x;
    volatile LAS unsigned* st;
};

__device__ __forceinline__ XcdBarrier xcd_barrier_post(unsigned* bar, volatile LAS unsigned* st) {
    XcdBarrier b; b.bar = bar; b.x = xb_xcc_id(); b.st = st;
    if (threadIdx.x == 0) (void)xb_add(&bar[XB_XCNT(b.x)], 1u);
    return b;
}
__device__ __forceinline__ void xcd_barrier_complete(unsigned* bar, unsigned x, unsigned& nloc, unsigned& nx) {
    const unsigned G = gridDim.x * gridDim.y * gridDim.z;
    unsigned sum, cnt, mine, sp = 0u;
    for (;;) {
        sum = 0u; cnt = 0u; mine = 0u;
#pragma unroll
        for (unsigned j = 0; j < 16; ++j) { const unsigned c = xb_ld(&bar[XB_XCNT(j)]); sum += c; cnt += (c > 0u) ? 1u : 0u; mine = (j == x) ? c : mine; }
        if (sum == G) break;
        __builtin_amdgcn_s_sleep(1);
        if ((++sp & 255u) == 0u) { if (xb_ld(&bar[XB_TMO])) break; if (sp > XB_SPIN_CAP) { atomicAdd(&bar[XB_TMO], 1u); break; } }
    }
    nloc = mine > 0u ? mine : 1u; nx = cnt > 0u ? cnt : 1u;
}

__device__ __forceinline__ void xcd_barrier(const XcdBarrier& b) {
    asm volatile("s_waitcnt vmcnt(0)" ::: "memory");
    __syncthreads();
    if (threadIdx.x == 0) {
        unsigned* bar = b.bar;
        __builtin_amdgcn_s_waitcnt(0);
        unsigned nloc = b.st[0], nx = b.st[1];
        if (nloc == 0u) { xcd_barrier_complete(bar, b.x, nloc, nx); b.st[0] = nloc; b.st[1] = nx; }
        const unsigned old = xb_add(&bar[XB_XSUB(b.x)], 1u);
        const unsigned gen = old / nloc;
        if (old + 1u == (gen + 1u) * nloc) {
            __builtin_amdgcn_fence(__ATOMIC_RELEASE, "agent");
            asm volatile("s_waitcnt vmcnt(0)" ::: "memory");
            const unsigned og = xb_add(&bar[XB_TOP], 1u);
            const unsigned tg = og / nx;
            if (og + 1u == (tg + 1u) * nx) xb_add(&bar[XB_TOPGEN], 1u);
            else XB_SPIN(xb_ld(&bar[XB_TOPGEN]) == tg, bar);
            __builtin_amdgcn_fence(__ATOMIC_ACQUIRE, "agent");
            xb_add(&bar[XB_XGEN(b.x)], 1u);
            asm volatile("s_waitcnt vmcnt(0)" ::: "memory");
        } else {
            XB_SPIN(xb_ld(&bar[XB_XGEN(b.x)]) == gen, bar);
            __builtin_amdgcn_fence(__ATOMIC_ACQUIRE, "agent");
            asm volatile("s_waitcnt vmcnt(0)" ::: "memory");
        }
    }
    __syncthreads();
}
__device__ __forceinline__ float wave_sum(float v) {
#pragma unroll
    for (int o = 1; o < 64; o <<= 1) v += __shfl_xor(v, o);
    return v;
}
__device__ __forceinline__ void p0_transpose_item(const float* W, int K, int N, bf16* WT, int row_off, LAS float* scr, int item, int lane) {
    const int nblk = N / 32, kb = item / nblk, nb = item % nblk, k0 = 64 * kb, n0 = 32 * nb;
#pragma unroll
    for (int i = 0; i < 8; ++i) { const int kk = 8 * i + (lane >> 3); const f32x4 w = __builtin_nontemporal_load((const f32x4*)(W + (size_t)(k0 + kk) * N + n0 + 4 * (lane & 7)));
        LAS float* d = scr + kk * 33 + 4 * (lane & 7); d[0] = w.x; d[1] = w.y; d[2] = w.z; d[3] = w.w; }
    LDS_WAIT(); asm volatile("" ::: "memory");
    const int c = lane & 7;
#pragma unroll
    for (int j = 0; j < 4; ++j) { const int n = (lane >> 3) + 8 * j; const LAS float* s = scr + (8 * c) * 33 + n;
        v4u o; o.x = pk2(s[0 * 33], s[1 * 33]); o.y = pk2(s[2 * 33], s[3 * 33]); o.z = pk2(s[4 * 33], s[5 * 33]); o.w = pk2(s[6 * 33], s[7 * 33]);
        *(GAS v4u*)(WT + (size_t)(row_off + n0 + n) * K + k0 + 8 * c) = o; }
    LDS_WAIT(); asm volatile("" ::: "memory");
}

typedef short bf16x8 __attribute__((ext_vector_type(8)));
typedef float f32x16 __attribute__((ext_vector_type(16)));
typedef short s16x4 __attribute__((ext_vector_type(4)));
typedef short v4i16_t __attribute__((ext_vector_type(4)));
#define MFMA32(a, b, c) __builtin_amdgcn_mfma_f32_32x32x16_bf16((a), (b), (c), 0, 0, 0)
#define WG_BAR() do { asm volatile("s_waitcnt vmcnt(0) lgkmcnt(0)" ::: "memory"); __builtin_amdgcn_s_barrier(); asm volatile("" ::: "memory"); } while (0)
#define LDS_BAR() do { asm volatile("s_waitcnt lgkmcnt(0)" ::: "memory"); __builtin_amdgcn_s_barrier(); asm volatile("" ::: "memory"); } while (0)

__device__ __forceinline__ bf16x8 frag_row(LAS unsigned char* img, int P, int row0, int s, int lane) {
    return *(const LAS bf16x8*)(img + (row0 + (lane & 31)) * P + (16 * s + 8 * (lane >> 5)) * 2);
}
__device__ __forceinline__ bf16x8 frag_tr(LAS unsigned char* img, int P, int k0, int n0, int lane) {
    const int h = lane >> 5, blk = (lane >> 4) & 1, q = (lane & 15) >> 2, p = lane & 3;
    LAS unsigned char* a = img + (k0 + 8 * h + q) * P + n0 * 2 + 32 * blk + 8 * p;
    const s16x4 lo = __builtin_bit_cast(s16x4, __builtin_amdgcn_ds_read_tr16_b64_v4i16((LAS v4i16_t*)a));
    const s16x4 hi = __builtin_bit_cast(s16x4, __builtin_amdgcn_ds_read_tr16_b64_v4i16((LAS v4i16_t*)(a + 4 * P)));
    return __builtin_shufflevector(lo, hi, 0, 1, 2, 3, 4, 5, 6, 7);
}
__device__ __forceinline__ float wave_sum_dpp(float v) {
#define DPP_(x, ctrl, rmask) __builtin_bit_cast(float, __builtin_amdgcn_update_dpp(0, __builtin_bit_cast(int, (x)), (ctrl), (rmask), 0xf, false))
    v += DPP_(v, 0xB1, 0xf);
    v += DPP_(v, 0x4E, 0xf);
    v += DPP_(v, 0x141, 0xf);
    v += DPP_(v, 0x140, 0xf);
    v += DPP_(v, 0x142, 0xa);
    v += DPP_(v, 0x143, 0xc);
#undef DPP_
    return __builtin_bit_cast(float, __builtin_amdgcn_readlane(__builtin_bit_cast(int, v), 63));
}
__device__ __forceinline__ float wave_incl_scan_dpp(float v) {
#define DPP_(x, ctrl, rmask) __builtin_bit_cast(float, __builtin_amdgcn_update_dpp(0, __builtin_bit_cast(int, (x)), (ctrl), (rmask), 0xf, false))
    v += DPP_(v, 0x111, 0xf); v += DPP_(v, 0x112, 0xf); v += DPP_(v, 0x114, 0xf); v += DPP_(v, 0x118, 0xf);
    v += DPP_(v, 0x142, 0xa); v += DPP_(v, 0x143, 0xc);
#undef DPP_
    return v;
}
__device__ __forceinline__ int crow(int i, int h) { return (i & 3) + 8 * (i >> 2) + 4 * h; }
__device__ __forceinline__ void store_tile_T(LAS unsigned char* img, int P, int n0, int m0, const f32x16& acc, int lane) {
    LAS unsigned char* p = img + (n0 + (lane & 31)) * P + (m0 + 4 * (lane >> 5)) * 2;
#pragma unroll
    for (int g = 0; g < 4; ++g) { v2u w; w.x = cvtpk(acc[4 * g], acc[4 * g + 1]); w.y = cvtpk(acc[4 * g + 2], acc[4 * g + 3]); *(LAS v2u*)(p + 16 * g) = w; }
}
__device__ __forceinline__ f32x16 zero16() { f32x16 z; for (int i = 0; i < 16; ++i) z[i] = 0.f; return z; }


__device__ __forceinline__ f32x16 ltri_tile(LAS unsigned char* X, LAS unsigned char* Y, int t, int lane) {
    f32x16 acc = zero16();
    const int mb = t ? 32 : 0, nb = (t == 2) ? 32 : 0;
#pragma unroll
    for (int ks = 0; ks < 4; ++ks) { if ((t == 0 && ks >= 2) || (t == 2 && ks < 2)) continue; acc = MFMA32(frag_tr(Y, 144, 16 * ks, nb, lane), frag_row(X, 144, mb, ks, lane), acc); }
    return acc;
}
__device__ __forceinline__ void ltri_store1(LAS unsigned char* img, int t, const f32x16& acc, int lane) { store_tile_T(img, 144, t ? 32 : 0, (t == 2) ? 32 : 0, acc, lane); }
__device__ __forceinline__ void tri_inverse64(LAS unsigned char* LF, LAS unsigned char* LOFF, LAS unsigned char* DD, LAS unsigned char* NI, LAS unsigned char* N2I, LAS unsigned char* SI, int lane) {
    const int b = lane >> 4; const int hh = lane >> 5, l31 = lane & 31;
    {
        unsigned lfa = (unsigned)(size_t)LF + (unsigned)b * (16u * 272u + 64u); asm volatile("" : "+v"(lfa));
        LAS unsigned char* lf = (LAS unsigned char*)(size_t)lfa;
        int c_o = lane & 15; asm volatile("" : "+v"(c_o));
        float Td[16];
#pragma unroll
        for (int i = 0; i < 16; ++i) {
            float a0 = (c_o == i) ? 1.f : 0.f, a1 = 0.f, a2 = 0.f, a3 = 0.f;
#pragma unroll
            for (int j4 = 0; j4 < (i + 3) / 4; ++j4) { const f32x4 l = *(const LAS f32x4*)(lf + i * 272 + j4 * 16);
                if (4 * j4 + 0 < i) a0 -= l.x * Td[4 * j4 + 0]; if (4 * j4 + 1 < i) a1 -= l.y * Td[4 * j4 + 1]; if (4 * j4 + 2 < i) a2 -= l.z * Td[4 * j4 + 2]; if (4 * j4 + 3 < i) a3 -= l.w * Td[4 * j4 + 3]; }
            Td[i] = (a0 + a1) + (a2 + a3);
        }
        asm volatile("" ::: "memory");
        LAS unsigned char* dd = DD + lane * 2;
#pragma unroll
        for (int bb = 0; bb < 4; ++bb)
#pragma unroll
            for (int ii = 0; ii < 16; ++ii) *(LAS bf16*)(dd + (16 * bb + ii) * 144) = (bf16)f2bf(bb == b ? Td[ii] : 0.f);
    }
    asm volatile("" ::: "memory");
    f32x16 sacc[3];
    {
        f32x16 p[3];
#pragma unroll
        for (int t = 0; t < 3; ++t) p[t] = ltri_tile(DD, LOFF, t, lane);
#pragma unroll
        for (int t = 0; t < 3; ++t) { ltri_store1(NI, t, p[t], lane);
#pragma unroll
            for (int r = 0; r < 16; ++r) sacc[t][r] = ((t != 1 && l31 == crow(r, hh)) ? 1.f : 0.f) - p[t][r]; }
    }
    asm volatile("" ::: "memory");
    {
        f32x16 p[3];
#pragma unroll
        for (int t = 0; t < 3; ++t) p[t] = ltri_tile(NI, NI, t, lane);
#pragma unroll
        for (int t = 0; t < 3; ++t) { ltri_store1(N2I, t, p[t], lane);
#pragma unroll
            for (int r = 0; r < 16; ++r) sacc[t][r] += p[t][r]; }
    }
    asm volatile("" ::: "memory");
    {
        f32x16 p[3];
#pragma unroll
        for (int t = 0; t < 3; ++t) p[t] = ltri_tile(NI, N2I, t, lane);
#pragma unroll
        for (int t = 0; t < 3; ++t)
#pragma unroll
            for (int r = 0; r < 16; ++r) sacc[t][r] -= p[t][r];
    }
    asm volatile("" ::: "memory");
#pragma unroll
    for (int t = 0; t < 3; ++t) ltri_store1(SI, t, sacc[t], lane);
    asm volatile("" ::: "memory");
}


__device__ __forceinline__ void inv_stepA(LAS unsigned char* LF, LAS unsigned char* DD, int lane) {
    const int b = lane >> 4;
    unsigned lfa = (unsigned)(size_t)LF + (unsigned)b * (16u * 272u + 64u); asm volatile("" : "+v"(lfa));
    LAS unsigned char* lf = (LAS unsigned char*)(size_t)lfa;
    int c_o = lane & 15; asm volatile("" : "+v"(c_o));
    float Td[16];
#pragma unroll
    for (int i = 0; i < 16; ++i) {
        float a0 = (c_o == i) ? 1.f : 0.f, a1 = 0.f, a2 = 0.f, a3 = 0.f;
#pragma unroll
        for (int j4 = 0; j4 < (i + 3) / 4; ++j4) { const f32x4 l = *(const LAS f32x4*)(lf + i * 272 + j4 * 16);
            if (4 * j4 + 0 < i) a0 -= l.x * Td[4 * j4 + 0]; if (4 * j4 + 1 < i) a1 -= l.y * Td[4 * j4 + 1]; if (4 * j4 + 2 < i) a2 -= l.z * Td[4 * j4 + 2]; if (4 * j4 + 3 < i) a3 -= l.w * Td[4 * j4 + 3]; }
        Td[i] = (a0 + a1) + (a2 + a3);
    }
    asm volatile("" ::: "memory");
    LAS unsigned char* dd = DD + lane * 2 + b * (16 * 144);
#pragma unroll
    for (int ii = 0; ii < 16; ++ii) *(LAS bf16*)(dd + ii * 144) = (bf16)(cvtpk(Td[ii], 0.f) & 0xffffu);
}
__device__ __forceinline__ void inv_zero_offdiag(LAS unsigned char* DD, int w, int lane) {
    const int bi = lane >> 4, bj = (bi + w) & 3; LAS unsigned char* p = DD + lane * 144 + bj * 32;
    *(LAS v4u*)p = (v4u){0u, 0u, 0u, 0u}; *(LAS v4u*)(p + 16) = (v4u){0u, 0u, 0u, 0u};
}
__device__ __forceinline__ f32x16 ltri_tile_rt(LAS unsigned char* X, LAS unsigned char* Y, int t, int lane) {
    f32x16 acc = zero16();
    const int mb = t ? 32 : 0, nb = (t == 2) ? 32 : 0;
    if (t != 2) {
#pragma unroll
        for (int ks = 0; ks < 2; ++ks) acc = MFMA32(frag_tr(Y, 144, 16 * ks, nb, lane), frag_row(X, 144, mb, ks, lane), acc);
    }
    if (t != 0) {
#pragma unroll
        for (int ks = 2; ks < 4; ++ks) acc = MFMA32(frag_tr(Y, 144, 16 * ks, nb, lane), frag_row(X, 144, mb, ks, lane), acc);
    }
    return acc;
}

namespace rk {
constexpr int P = 144, IMG = 64 * P;
constexpr int O_KKD = 0, O_RD = IMG, O_BI = 2 * IMG, O_KI = 3 * IMG, O_KET = 4 * IMG, O_BET = 5 * IMG, O_VT = 6 * IMG  , O_AKK = 7 * IMG, O_UT = 7 * IMG  ,
              O_ARB = 8 * IMG, O_ARK = 9 * IMG, O_T = 10 * IMG, O_XT = 11 * IMG, O_HT = 12 * IMG, O_LF = 13 * IMG, PLF = 272, O_GAM = O_LF + 64 * PLF, O_WTOT = O_GAM + 256, O_END = O_WTOT + 2048;
static_assert(O_END <= 143360, "rwkv chunk LDS map");
}
struct RkStep { int row0, T, h, d, n, nch; const float* sinit; float* sfin; };
__device__ __forceinline__ bool rk_unit(int u, RkStep& s, const float* state_rwkv, float* RS) {
    if (u >= 4608) return false;
    if (u < 512) { const int bl = u >> 7, rem = u & 127; s.h = rem >> 1; s.d = rem & 1; s.row0 = MC + bl * 1024; s.T = 1024; s.nch = 16; s.sinit = state_rwkv + ((size_t)(bl * 2 + s.d) * 64 + s.h) * 4096; s.sfin = nullptr; }
    else { const int ct = u - 512, b = ct >> 7, rem = ct & 127; s.h = rem >> 1; s.d = rem & 1; s.row0 = b * 256; s.T = 256; s.nch = 4; s.sinit = nullptr; s.sfin = RS + ((size_t)(b * 2 + s.d) * 64 + s.h) * 4096; }
    s.n = 0; return true;
}
__device__ __forceinline__ int rk_row(const RkStep& s, int tau) { const int tt = s.n * 64 + tau; return s.row0 + (s.d ? (s.T - 1 - tt) : tt); }

__device__ __forceinline__ void rwkv_chunk_phase(LAS unsigned char* lds, int tid, int lane, int wave, int bx, int G, const bf16* RKVZ, const bf16* LWIC, const float* k_k, const float* k_a,
                                                 const float* state_rwkv, float* RS, bf16* YF, bf16* YB,
                                                 const float* gw_in, const float* gw_ab, const float* gw_out, bf16* WIN1, bf16* GOUT1) {
    using namespace rk;
    RkStep st;
    int u = bx;
    bool have = rk_unit(u, st, state_rwkv, RS);
    v4u qr, qk, qv, qw, qi; qr = qk = qv = qw = qi = (v4u){0u, 0u, 0u, 0u};
    if (have) { const size_t o = (size_t)rk_row(st, 8 * wave + (lane >> 3)) * D + st.h * 64 + (lane & 7) * 8;
        qr = *(const v4u*)(RKVZ + o); qk = *(const v4u*)(RKVZ + (size_t)M * D + o); qv = *(const v4u*)(RKVZ + (size_t)2 * M * D + o); qw = *(const v4u*)(LWIC + (size_t)st.d * M * D + o); qi = *(const v4u*)(LWIC + (size_t)(2 + st.d) * M * D + o); }
    f32x16 hacc = zero16();
    const int tb = (wave & 3) >> 1, vb = wave & 1;
    const int lane_in = lane; float kkc = 0.f, kac = 0.f;
    float tv[32]; bf16* tdst = nullptr; bool tpend = false; int tslot = 0;
#define TR_ITEMS 161
#define TR_FINISH() do { if (tpend) { _Pragma("unroll") for (int k_ = 0; k_ < 32; ++k_) asm volatile("" : "+v"(tv[k_])); \
        _Pragma("unroll") for (int q_ = 0; q_ < 4; ++q_) { v4u w_; w_.x = cvtpk(tv[8 * q_], tv[8 * q_ + 1]); w_.y = cvtpk(tv[8 * q_ + 2], tv[8 * q_ + 3]); w_.z = cvtpk(tv[8 * q_ + 4], tv[8 * q_ + 5]); w_.w = cvtpk(tv[8 * q_ + 6], tv[8 * q_ + 7]); *(v4u*)(tdst + 8 * q_) = w_; } \
        tpend = false; } } while (0)
#define TR_START() do { const int slot_ = tslot * 2 + (wave >> 2); ++tslot; if (slot_ < TR_ITEMS) { const int item_ = bx * TR_ITEMS + slot_, nb_ = item_ >> 7, k0_ = (item_ & 127) * 32; const float* src_; int ns_; \
        if (nb_ < 256) { src_ = gw_in + (size_t)k0_ * 16384 + nb_ * 64 + lane_in; ns_ = 16384; tdst = WIN1 + (size_t)(nb_ * 64 + lane_in) * 4096 + k0_; } \
        else if (nb_ < 258) { src_ = gw_ab + (size_t)k0_ * 128 + (nb_ - 256) * 64 + lane_in; ns_ = 128; tdst = WIN1 + (size_t)(16384 + (nb_ - 256) * 64 + lane_in) * 4096 + k0_; } \
        else { src_ = gw_out + (size_t)k0_ * 4096 + (nb_ - 258) * 64 + lane_in; ns_ = 4096; tdst = GOUT1 + (size_t)((nb_ - 258) * 64 + lane_in) * 4096 + k0_; } \
        _Pragma("unroll") for (int k_ = 0; k_ < 32; ++k_) tv[k_] = __builtin_nontemporal_load(src_ + (size_t)k_ * ns_); tpend = true; } } while (0)
    while (have) {
        int lane = lane_in; asm volatile("" : "+v"(lane));
        const int hh = lane >> 5, l31 = lane & 31;
        if (st.n == 0) { const int c = st.h * 64 + lane; kkc = k_k[c]; kac = k_a[c]; }
        if (st.n == 0 && wave >= 4) {
            if (st.sinit) {
#pragma unroll
                for (int g = 0; g < 4; ++g) { const f32x4 v = *(const f32x4*)(st.sinit + (size_t)(vb * 32 + l31) * 64 + tb * 32 + 8 * g + 4 * hh); hacc[4 * g] = v.x; hacc[4 * g + 1] = v.y; hacc[4 * g + 2] = v.z; hacc[4 * g + 3] = v.w; }
            } else hacc = zero16();
            store_tile_T(lds + O_HT, P, vb * 32, tb * 32, hacc, lane);
        }
        float fr[8], fk[8], fw[8], fi[8];
        {
            asm volatile("" : "+v"(qr), "+v"(qk), "+v"(qv), "+v"(qw), "+v"(qi));
            const int ro = (8 * wave + (lane >> 3)) * P + (lane & 7) * 16;
            *(LAS v4u*)(lds + O_RD + ro) = qr; *(LAS v4u*)(lds + O_KKD + ro) = qk; *(LAS v4u*)(lds + O_BI + ro) = qw; *(LAS v4u*)(lds + O_KI + ro) = qi; *(LAS v4u*)(lds + O_VT + ro) = qv;
#pragma unroll
            for (int i = 0; i < 8; ++i) { const int a = (8 * wave + i) * P + lane * 2;
                fr[i] = bf2f(*(const LAS bf16*)(lds + O_RD + a)); fk[i] = bf2f(*(const LAS bf16*)(lds + O_KKD + a)); fw[i] = bf2f(*(const LAS bf16*)(lds + O_BI + a)); fi[i] = bf2f(*(const LAS bf16*)(lds + O_KI + a)); }
            asm volatile("" ::: "memory");
        }
        float gl[8]; { float run = 0.f;
#pragma unroll
            for (int i = 0; i < 8; ++i) { run += fw[i]; gl[i] = run; } }
        ((LAS float*)(lds + O_WTOT))[wave * 64 + lane] = gl[7];
        LDS_BAR();
        float prefix = 0.f, gtot = 0.f;
#pragma unroll
        for (int w2 = 0; w2 < 8; ++w2) { const float t = ((LAS float*)(lds + O_WTOT))[w2 * 64 + lane]; if (w2 < wave) prefix += t; gtot += t; }
        {
            float ket[8], bet[8];
            float eprev = __expf(prefix);
            const float egt = __expf(gtot); if (wave == 0) ((LAS float*)(lds + O_GAM))[lane] = egt;
#pragma unroll
            for (int i = 0; i < 8; ++i) {
                const float Gi = prefix + gl[i];
                const float kkv = fk[i] * kkc; const float nrm = wave_sum_dpp(kkv * kkv); const float kk = kkv * rsqrtf(nrm + 1e-6f);
                const float bb = kk * fi[i], kt = fk[i] * (1.f + (fi[i] - 1.f) * kac);
                const float eG = __expf(Gi), enG = __builtin_amdgcn_rcpf(eG), eC = egt * enG;
                const int tau = 8 * wave + i;
                *(LAS bf16*)(lds + O_KKD + tau * P + lane * 2) = (bf16)cvtpk(kk * eprev, 0.f);
                *(LAS bf16*)(lds + O_RD + tau * P + lane * 2) = (bf16)cvtpk(fr[i] * eG, 0.f);
                *(LAS bf16*)(lds + O_BI + tau * P + lane * 2) = (bf16)cvtpk(bb * enG, 0.f);
                *(LAS bf16*)(lds + O_KI + tau * P + lane * 2) = (bf16)cvtpk(kt * enG, 0.f);
                ket[i] = kt * eC; bet[i] = -bb * eC; eprev = eG;
            }
            v4u w;
            w.x = cvtpk(ket[0], ket[1]); w.y = cvtpk(ket[2], ket[3]); w.z = cvtpk(ket[4], ket[5]); w.w = cvtpk(ket[6], ket[7]); *(LAS v4u*)(lds + O_KET + lane * P + 16 * wave) = w;
            w.x = cvtpk(bet[0], bet[1]); w.y = cvtpk(bet[2], bet[3]); w.z = cvtpk(bet[4], bet[5]); w.w = cvtpk(bet[6], bet[7]); *(LAS v4u*)(lds + O_BET + lane * P + 16 * wave) = w;
        }
        LDS_BAR();
        RkStep nx = st; bool nhave = true; int nu = u;
        if (st.n + 1 < st.nch) nx.n = st.n + 1; else { nu = u + G; nhave = rk_unit(nu, nx, state_rwkv, RS); }
        if (nhave) { const size_t o = (size_t)rk_row(nx, 8 * wave + (lane >> 3)) * D + nx.h * 64 + (lane & 7) * 8;
            qr = *(const v4u*)(RKVZ + o); qk = *(const v4u*)(RKVZ + (size_t)M * D + o); qv = *(const v4u*)(RKVZ + (size_t)2 * M * D + o); qw = *(const v4u*)(LWIC + (size_t)nx.d * M * D + o); qi = *(const v4u*)(LWIC + (size_t)(2 + nx.d) * M * D + o); }
#define RK_TILE(mat_, kind_) do { const int mat = (mat_), sb = ((kind_) == 1) ? 1 : 0, tbb = ((kind_) == 0) ? 0 : 1; \
            LAS unsigned char* srcS = lds + ((mat & 1) ? O_KI : O_BI); LAS unsigned char* srcT = lds + ((mat & 2) ? O_RD : O_KKD); \
            f32x16 acc = zero16(); \
            _Pragma("unroll") for (int ks = 0; ks < 4; ++ks) acc = MFMA32(frag_row(srcS, P, sb * 32, ks, lane), frag_row(srcT, P, tbb * 32, ks, lane), acc); \
            const int t = tbb * 32 + l31; \
            LAS unsigned char* dst = lds + (mat == 0 ? O_T   : (mat == 1 ? O_AKK : (mat == 2 ? O_ARB : O_ARK))); \
            if (sb == tbb) {                                                \
                const int dlt = l31 - 4 * hh; \
                _Pragma("unroll") for (int i = 0; i < 16; ++i) { const int ci = (i & 3) + 8 * (i >> 2); const bool keep = (mat < 2) ? (ci < dlt) : (ci <= dlt); acc[i] = keep ? (mat == 2 ? -acc[i] : acc[i]) : 0.f; } \
                if (mat == 0) {                                             \
                    _Pragma("unroll") for (int g = 0; g < 4; ++g) *(LAS f32x4*)(lds + O_LF + t * PLF + (sb * 32 + 8 * g + 4 * hh) * 4) = (f32x4){acc[4 * g], acc[4 * g + 1], acc[4 * g + 2], acc[4 * g + 3]}; \
                    _Pragma("unroll") for (int i = 0; i < 16; ++i) { const int ci = (i & 3) + 8 * (i >> 2) + 4 * hh; if ((ci >> 4) == (l31 >> 4)) acc[i] = 0.f; } \
                } \
            } else if (mat == 2) { _Pragma("unroll") for (int i = 0; i < 16; ++i) acc[i] = -acc[i]; } \
            store_tile_T(dst, P, tbb * 32, sb * 32, acc, lane); } while (0)
        RK_TILE((wave < 3) ? 0 : (wave < 6 ? 2 : 1), (wave < 6) ? (wave % 3) : (wave - 6));
        LDS_BAR();
        f32x16 yacc = zero16(), isacc = zero16();
        if (wave == 3) inv_stepA(lds + O_LF, lds + O_BI, lane);
        asm volatile("" ::: "memory");
#define RK_XTILE() do { \
            f32x16 acc = zero16(); \
_Pragma("unroll") \
            for (int ks = 0; ks < 4; ++ks) { if (ks < 2 * (tb + 1)) acc = MFMA32(frag_row(lds + O_AKK, P, tb * 32, ks, lane), frag_tr(lds + O_VT, P, 16 * ks, vb * 32, lane), acc); } \
_Pragma("unroll") \
            for (int ks = 0; ks < 4; ++ks) acc = MFMA32(frag_row(lds + O_KKD, P, tb * 32, ks, lane), frag_row(lds + O_HT, P, vb * 32, ks, lane), acc); \
            store_tile_T(lds + O_XT, P, vb * 32, tb * 32, acc, lane); } while (0)
        if (wave >= 4) RK_TILE((wave == 4) ? 1 : 3, (wave == 4) ? 2 : (wave - 5));
#define RK_YPART() do { \
            _Pragma("unroll") for (int ks = 0; ks < 4; ++ks) yacc = MFMA32(frag_row(lds + O_HT, P, vb * 32, ks, lane), frag_row(lds + O_RD, P, tb * 32, ks, lane), yacc); } while (0)
        if (wave < 3) { inv_zero_offdiag(lds + O_BI, wave + 1, lane); RK_YPART(); }
        LDS_BAR();
        if (wave == 3) RK_YPART();
        if (wave >= 4) RK_XTILE();
        if ((wave & 3) == 3) { TR_FINISH(); TR_START(); }
        if (wave < 3) { const f32x16 p_ = ltri_tile_rt(lds + O_BI, lds + O_T, wave, lane); ltri_store1(lds + O_KI, wave, p_, lane);
#pragma unroll
            for (int r = 0; r < 16; ++r) isacc[r] = ((wave != 1 && l31 == crow(r, hh)) ? 1.f : 0.f) - p_[r]; }
        LDS_BAR();
        if (wave < 3) { const f32x16 p_ = ltri_tile_rt(lds + O_KI, lds + O_KI, wave, lane); ltri_store1(lds + O_LF, wave, p_, lane);
#pragma unroll
            for (int r = 0; r < 16; ++r) isacc[r] += p_[r]; }
        LDS_BAR();
        if (wave < 3) { const f32x16 p_ = ltri_tile_rt(lds + O_KI, lds + O_LF, wave, lane);
#pragma unroll
            for (int r = 0; r < 16; ++r) isacc[r] -= p_[r];
            ltri_store1(lds + O_T, wave, isacc, lane); }
        LDS_BAR();
        if (wave < 3) { const f32x16 p_ = ltri_tile_rt(lds + O_T, lds + O_BI, wave, lane); ltri_store1(lds + O_KI, wave, p_, lane); }
#undef RK_YPART
#undef RK_XTILE
#undef RK_TILE
        LDS_BAR();
        if (wave >= 4) {
            f32x16 acc = zero16();
#pragma unroll
            for (int ks = 0; ks < 4; ++ks) { if (ks < 2 * (tb + 1)) acc = MFMA32(frag_row(lds + O_KI, P, tb * 32, ks, lane), frag_row(lds + O_XT, P, vb * 32, ks, lane), acc); }
            store_tile_T(lds + O_UT, P, vb * 32, tb * 32, acc, lane);
        }
        LDS_BAR();
        if (wave < 4) {
#pragma unroll
            for (int ks = 0; ks < 4; ++ks) { if (ks < 2 * (tb + 1)) { yacc = MFMA32(frag_tr(lds + O_VT, P, 16 * ks, vb * 32, lane), frag_row(lds + O_ARK, P, tb * 32, ks, lane), yacc);
                                                                      yacc = MFMA32(frag_row(lds + O_UT, P, vb * 32, ks, lane), frag_row(lds + O_ARB, P, tb * 32, ks, lane), yacc); } }
            bf16* Yd = (st.d ? YB : YF) + (size_t)rk_row(st, tb * 32 + l31) * D + st.h * 64 + vb * 32 + 4 * hh;
#pragma unroll
            for (int g = 0; g < 4; ++g) { v2u w; w.x = cvtpk(yacc[4 * g], yacc[4 * g + 1]); w.y = cvtpk(yacc[4 * g + 2], yacc[4 * g + 3]); *(v2u*)(Yd + 8 * g) = w; }
        } else {
#pragma unroll
            for (int g = 0; g < 4; ++g) { const f32x4 gm = *(const LAS f32x4*)(lds + O_GAM + (tb * 32 + 8 * g + 4 * hh) * 4); hacc[4 * g] *= gm.x; hacc[4 * g + 1] *= gm.y; hacc[4 * g + 2] *= gm.z; hacc[4 * g + 3] *= gm.w; }
#pragma unroll
            for (int ks = 0; ks < 4; ++ks) hacc = MFMA32(frag_row(lds + O_KET, P, tb * 32, ks, lane), frag_tr(lds + O_VT, P, 16 * ks, vb * 32, lane), hacc);
#pragma unroll
            for (int ks = 0; ks < 4; ++ks) hacc = MFMA32(frag_row(lds + O_BET, P, tb * 32, ks, lane), frag_row(lds + O_UT, P, vb * 32, ks, lane), hacc);
            store_tile_T(lds + O_HT, P, vb * 32, tb * 32, hacc, lane);
            if (st.n + 1 == st.nch && st.sfin) {
#pragma unroll
                for (int g = 0; g < 4; ++g) *(f32x4*)(st.sfin + (size_t)(vb * 32 + l31) * 64 + tb * 32 + 8 * g + 4 * hh) = (f32x4){hacc[4 * g], hacc[4 * g + 1], hacc[4 * g + 2], hacc[4 * g + 3]};
            }
        }
        LDS_BAR();
        st = nx; have = nhave; u = nu;
    }
    if ((wave & 3) == 3) { TR_FINISH(); while (tslot * 2 < TR_ITEMS) { TR_START(); TR_FINISH(); } }
#undef TR_FINISH
#undef TR_START
#undef TR_ITEMS
}

namespace gd {
constexpr int P128 = 272, P64 = 144;
constexpr int O_K = 0, O_V = 17408, O_ST = 34816, O_QK = 69632, O_R1 = 78848, O_R2 = 97280, O_R3 = 115712, O_VEC = 134144, O_END = O_VEC + 1040;
constexpr int O_LOFF = O_R1, O_DD = O_R1 + 9216, O_VN = O_R1, O_Q = O_R2, O_WNEG = O_R2, O_LF = O_R3, O_NI = O_R3, O_N2I = O_R3 + 9216, O_TB = O_R3, O_TBG = O_R3 + 9216, O_VNS = O_R3, PLF = 272;
constexpr int V_GC = O_VEC, V_BETA = O_VEC + 256, V_EGC = O_VEC + 512, V_ELAST = O_VEC + 768, V_EGL = O_VEC + 1024;
static_assert(O_END <= 143360, "gdn chunk LDS map");
}
struct GdStep { int row0, T, h, d, n, nch; const float* sinit; float* sfin; };
__device__ __forceinline__ bool gd_unit(int u, GdStep& s, const float* state_gdn, float* GS) {
    if (u >= 2304) return false;
    if (u < 256) { const int bl = u >> 6, rem = u & 63; s.h = rem >> 1; s.d = rem & 1; s.row0 = MC + bl * 1024; s.T = 1024; s.nch = 16; s.sinit = state_gdn + ((size_t)(bl * 2 + s.d) * 32 + s.h) * 16384; s.sfin = nullptr; }
    else { const int ct = u - 256, b = ct >> 6, rem = ct & 63; s.h = rem >> 1; s.d = rem & 1; s.row0 = b * 256; s.T = 256; s.nch = 4; s.sinit = nullptr; s.sfin = GS + ((size_t)(b * 2 + s.d) * 32 + s.h) * 16384; }
    s.n = 0; return true;
}
__device__ __forceinline__ int gd_row(const GdStep& s, int tau) { const int tt = s.n * 64 + tau; return s.row0 + (s.d ? (s.T - 1 - tt) : tt); }

__device__ __forceinline__ void gdn_chunk_phase(LAS unsigned char* lds, int tid, int lane, int wave, int bx, int G, const bf16* QKVc, const float* GB, const float* state_gdn, float* GS, bf16* OF, bf16* OB) {
    using namespace gd;
    GdStep st; int u = bx;
    bool have = gd_unit(u, st, state_gdn, GS);
    const int lane_in = lane;
    v4u pq[2], pkk[2], pvv[2]; float pg = 0.f, pb = 0.f;
    if (have) {
#pragma unroll
        for (int e = 0; e < 2; ++e) { const int p = tid + 512 * e, r = p >> 4, ch = p & 15; const bf16* src = QKVc + (size_t)gd_row(st, r) * 12288 + st.h * 128 + ch * 8;
            pq[e] = *(const v4u*)src; pkk[e] = *(const v4u*)(src + 4096); pvv[e] = *(const v4u*)(src + 8192); }
        if (wave == 0) { const size_t o = (size_t)gd_row(st, lane) * 128 + st.d * 64 + st.h; pg = GB[o]; pb = GB[o + 32]; }
    }
    f32x16 sacc[2]; sacc[0] = zero16(); sacc[1] = zero16();
    const int ib = wave >> 2, vb = wave & 3;
    const int db = wave >> 1, vb2 = 2 * (wave & 1);
    while (have) {
        int lane = lane_in; asm volatile("" : "+v"(lane));
        const int hh = lane >> 5, l31 = lane & 31;
        if (st.n == 0) {
#pragma unroll
            for (int t = 0; t < 2; ++t) {
                if (st.sinit) {
#pragma unroll
                    for (int r = 0; r < 16; ++r) sacc[t][r] = st.sinit[(size_t)(db * 32 + crow(r, hh)) * 128 + (vb2 + t) * 32 + l31];
                } else sacc[t] = zero16();
                store_tile_T(lds + O_ST, P128, (vb2 + t) * 32, db * 32, sacc[t], lane);
            }
        }
#pragma unroll
        for (int e = 0; e < 2; ++e) { const int p = tid + 512 * e, r = p >> 4, ch = p & 15;
            *(LAS v4u*)(lds + O_Q + r * P128 + ch * 16) = pq[e]; *(LAS v4u*)(lds + O_K + r * P128 + ch * 16) = pkk[e]; *(LAS v4u*)(lds + O_V + r * P128 + ch * 16) = pvv[e]; }
        if (wave == 0) {
            const float x = wave_incl_scan_dpp(pg);
            const float glast = __builtin_bit_cast(float, __builtin_amdgcn_readlane(__builtin_bit_cast(int, x), 63));
            ((LAS float*)(lds + V_GC))[lane] = x; ((LAS float*)(lds + V_BETA))[lane] = pb; ((LAS float*)(lds + V_EGC))[lane] = __expf(x); ((LAS float*)(lds + V_ELAST))[lane] = __expf(glast - x);
            if (lane == 0) ((LAS float*)(lds + V_EGL))[0] = __expf(glast);
        }
        LDS_BAR();
        GdStep nx = st; bool nhave = true; int nu = u;
        if (st.n + 1 < st.nch) nx.n = st.n + 1; else { nu = u + G; nhave = gd_unit(nu, nx, state_gdn, GS); }
        if (nhave) {
#pragma unroll
            for (int e = 0; e < 2; ++e) { const int p = tid + 512 * e, r = p >> 4, ch = p & 15; const bf16* src = QKVc + (size_t)gd_row(nx, r) * 12288 + nx.h * 128 + ch * 8;
                pq[e] = *(const v4u*)src; pkk[e] = *(const v4u*)(src + 4096); pvv[e] = *(const v4u*)(src + 8192); }
            if (wave == 0) { const size_t o = (size_t)gd_row(nx, lane) * 128 + nx.d * 64 + nx.h; pg = GB[o]; pb = GB[o + 32]; }
        }
        {
            const int mat = wave >> 2, ib2 = (wave >> 1) & 1, jb = wave & 1;
            if (jb <= ib2) {
                f32x16 acc = zero16();
#pragma unroll
                for (int ks = 0; ks < 8; ++ks) acc = MFMA32(frag_row(lds + O_K, P128, jb * 32, ks, lane), frag_row(lds + (mat ? O_Q : O_K), P128, ib2 * 32, ks, lane), acc);
                const int i = ib2 * 32 + l31; const float gi = ((LAS float*)(lds + V_GC))[i]; const float bi = mat ? 1.f : ((LAS float*)(lds + V_BETA))[i];
                const bool diag = (jb == ib2);
#pragma unroll
                for (int g = 0; g < 4; ++g) { const f32x4 gj = *(const LAS f32x4*)(lds + V_GC + (jb * 32 + 8 * g + 4 * hh) * 4);
#pragma unroll
                    for (int e = 0; e < 4; ++e) { const int j = jb * 32 + 8 * g + 4 * hh + e; const bool keep = !diag || (mat ? (j <= i) : (j < i));
                        const float ex = __expf(fminf(gi - gj[e], 0.f)); acc[4 * g + e] = keep ? acc[4 * g + e] * ex * bi : 0.f; } }
                if (mat == 0) {
                    if (diag) {
#pragma unroll
                        for (int g = 0; g < 4; ++g) *(LAS f32x4*)(lds + O_LF + i * PLF + (jb * 32 + 8 * g + 4 * hh) * 4) = (f32x4){acc[4 * g], acc[4 * g + 1], acc[4 * g + 2], acc[4 * g + 3]};
#pragma unroll
                        for (int r = 0; r < 16; ++r) { const int j = jb * 32 + crow(r, hh); if ((j >> 4) == (i >> 4)) acc[r] = 0.f; }
                    }
                    store_tile_T(lds + O_LOFF, P64, ib2 * 32, jb * 32, acc, lane);
                } else store_tile_T(lds + O_QK, P64, ib2 * 32, jb * 32, acc, lane);
            }
        }
        LDS_BAR();
        if (wave == 3) inv_stepA(lds + O_LF, lds + O_DD, lane);
        asm volatile("" ::: "memory");
        f32x16 oacc = zero16(), isacc = zero16();
#define GD_QS() do { \
        _Pragma("unroll") for (int ks = 0; ks < 8; ++ks) oacc = MFMA32(frag_row(lds + O_ST, P128, vb * 32, ks, lane), frag_row(lds + O_Q, P128, ib * 32, ks, lane), oacc); \
        { const float eg = ((LAS float*)(lds + V_EGC))[ib * 32 + l31]; _Pragma("unroll") for (int r = 0; r < 16; ++r) oacc[r] *= eg; } } while (0)
        if (wave < 3) inv_zero_offdiag(lds + O_DD, wave + 1, lane);
        if (wave != 3) GD_QS();
        LDS_BAR();
        if (wave == 3) GD_QS();
        if (wave < 3) { const f32x16 p_ = ltri_tile_rt(lds + O_DD, lds + O_LOFF, wave, lane); ltri_store1(lds + O_NI, wave, p_, lane);
#pragma unroll
            for (int r = 0; r < 16; ++r) isacc[r] = ((wave != 1 && l31 == crow(r, hh)) ? 1.f : 0.f) - p_[r]; }
        LDS_BAR();
        if (wave < 3) { const f32x16 p_ = ltri_tile_rt(lds + O_NI, lds + O_NI, wave, lane); ltri_store1(lds + O_N2I, wave, p_, lane);
#pragma unroll
            for (int r = 0; r < 16; ++r) isacc[r] += p_[r]; }
        LDS_BAR();
        if (wave < 3) { const f32x16 p_ = ltri_tile_rt(lds + O_NI, lds + O_N2I, wave, lane);
#pragma unroll
            for (int r = 0; r < 16; ++r) isacc[r] -= p_[r];
            ltri_store1(lds + O_LOFF, wave, isacc, lane); }
        LDS_BAR();
        if (wave < 3) {
            const int nb = (wave == 2) ? 32 : 0; f32x16 tb_ = ltri_tile_rt(lds + O_LOFF, lds + O_DD, wave, lane), tg_ = tb_;
#pragma unroll
            for (int g = 0; g < 4; ++g) { const f32x4 bt = *(const LAS f32x4*)(lds + V_BETA + (nb + 8 * g + 4 * hh) * 4); const f32x4 eg = *(const LAS f32x4*)(lds + V_EGC + (nb + 8 * g + 4 * hh) * 4);
#pragma unroll
                for (int e = 0; e < 4; ++e) { tb_[4 * g + e] *= bt[e]; tg_[4 * g + e] *= bt[e] * eg[e]; } }
            ltri_store1(lds + O_TB, wave, tb_, lane); ltri_store1(lds + O_TBG, wave, tg_, lane);
        }
#undef GD_QS
        LDS_BAR();
        f32x16 uacc = zero16();
#pragma unroll
        for (int ks = 0; ks < 4; ++ks) { if (ks < 2 * (ib + 1)) uacc = MFMA32(frag_row(lds + O_TB, P64, ib * 32, ks, lane), frag_tr(lds + O_V, P128, 16 * ks, vb * 32, lane), uacc); }
        {
            const int ibw = wave & 1; f32x16 acc = zero16();
#pragma unroll
            for (int ks = 0; ks < 4; ++ks) { if (ks < 2 * (ibw + 1)) acc = MFMA32(frag_tr(lds + O_K, P128, 16 * ks, db * 32, lane), frag_row(lds + O_TBG, P64, ibw * 32, ks, lane), acc); }
#pragma unroll
            for (int r = 0; r < 16; ++r) acc[r] = -acc[r];
            store_tile_T(lds + O_WNEG, P128, ibw * 32, db * 32, acc, lane);
        }
        LDS_BAR();
#pragma unroll
        for (int ks = 0; ks < 8; ++ks) uacc = MFMA32(frag_row(lds + O_WNEG, P128, ib * 32, ks, lane), frag_row(lds + O_ST, P128, vb * 32, ks, lane), uacc);
        store_tile_T(lds + O_VN, P64, vb * 32, ib * 32, uacc, lane);
#pragma unroll
        for (int g = 0; g < 4; ++g) { const f32x4 el = *(const LAS f32x4*)(lds + V_ELAST + (ib * 32 + 8 * g + 4 * hh) * 4); uacc[4 * g] *= el.x; uacc[4 * g + 1] *= el.y; uacc[4 * g + 2] *= el.z; uacc[4 * g + 3] *= el.w; }
        store_tile_T(lds + O_VNS, P64, vb * 32, ib * 32, uacc, lane);
        LDS_BAR();
#pragma unroll
        for (int ks = 0; ks < 4; ++ks) { if (ks < 2 * (ib + 1)) oacc = MFMA32(frag_row(lds + O_VN, P64, vb * 32, ks, lane), frag_row(lds + O_QK, P64, ib * 32, ks, lane), oacc); }
        { bf16* Od = (st.d ? OB : OF) + (size_t)gd_row(st, ib * 32 + l31) * D + st.h * 128 + vb * 32 + 4 * hh;
#pragma unroll
          for (int g = 0; g < 4; ++g) { v2u w; w.x = cvtpk(oacc[4 * g], oacc[4 * g + 1]); w.y = cvtpk(oacc[4 * g + 2], oacc[4 * g + 3]); *(v2u*)(Od + 8 * g) = w; } }
        {
            const float egl = ((LAS float*)(lds + V_EGL))[0];
#pragma unroll
            for (int t = 0; t < 2; ++t)
#pragma unroll
                for (int r = 0; r < 16; ++r) sacc[t][r] *= egl;
#pragma unroll
            for (int ks = 0; ks < 4; ++ks) { const bf16x8 ka = frag_tr(lds + O_K, P128, 16 * ks, db * 32, lane);
                sacc[0] = MFMA32(ka, frag_row(lds + O_VNS, P64, vb2 * 32, ks, lane), sacc[0]); sacc[1] = MFMA32(ka, frag_row(lds + O_VNS, P64, (vb2 + 1) * 32, ks, lane), sacc[1]); }
            store_tile_T(lds + O_ST, P128, vb2 * 32, db * 32, sacc[0], lane); store_tile_T(lds + O_ST, P128, (vb2 + 1) * 32, db * 32, sacc[1], lane);
            if (st.n + 1 == st.nch && st.sfin) {
#pragma unroll
                for (int t = 0; t < 2; ++t)
#pragma unroll
                    for (int r = 0; r < 16; ++r) st.sfin[(size_t)(db * 32 + crow(r, hh)) * 128 + (vb2 + t) * 32 + l31] = sacc[t][r];
            }
        }
        LDS_BAR();
        st = nx; have = nhave; u = nu;
    }
}

struct MultiOrder {
    int G, c;
    int nA, nNA, pmStrideA, pnStrideA;
    int nB, pmBaseB, pnBaseB;
    int ntFull, ksplit;
    __device__ __forceinline__ bool next(int i, pg8::Unit& u) const {
        const int L = i * G + c; const int perA = NPAN * nNA, totA = nA * perA, perB = NPAN * ksplit;
        if (L >= totA + nB * perB) return false;
        int pm, pn, k0 = 0, nt = ntFull;
        if (L < totA) {
            const int g = L / perA; int wgid = L - g * perA;
            { const int nwg = perA, q = nwg / 8, r = nwg % 8, xcd = wgid % 8, off = wgid / 8; wgid = (xcd < r ? xcd * (q + 1) : r * (q + 1) + (xcd - r) * q) + off; }
            const int nig = 8 * nNA, gid = wgid / nig, fm = gid * 8, gsz = (NPAN - fm) < 8 ? (NPAN - fm) : 8;
            pm = g * pmStrideA + fm + ((wgid % nig) % gsz); pn = g * pnStrideA + (wgid % nig) / gsz;
        } else {
            const int l = L - totA; const int gB = l / perB, rem = l - gB * perB, pmm = rem / ksplit, kq = rem - pmm * ksplit;
            pm = pmBaseB + gB * NPAN + pmm; pn = pnBaseB + gB; nt = ntFull / ksplit; k0 = kq * nt * 64;
        }
        u = pg8::Unit{pm, pn, k0, nt}; return true;
    }
    __device__ __forceinline__ void a_ready(const pg8::Unit&) const {}
    __device__ __forceinline__ void done(const pg8::Unit&) const {}
};

typedef pg8::f32x4 A4;
__device__ __forceinline__ float red8(float v) { v += __shfl_xor(v, 1); v += __shfl_xor(v, 2); v += __shfl_xor(v, 4); return v; }
__device__ __forceinline__ void bf8(v4u w, f32x4& lo, f32x4& hi) { v2u a; a.x = w.x; a.y = w.y; lo = bf4(a); a.x = w.z; a.y = w.w; hi = bf4(a); }
__device__ __forceinline__ v4u pk8(f32x4 lo, f32x4 hi) { v4u r; r.x = pk2(lo.x, lo.y); r.y = pk2(lo.z, lo.w); r.z = pk2(hi.x, hi.y); r.w = pk2(hi.z, hi.w); return r; }
struct EpiP2 {
    static constexpr bool PERM = true, AFTER_DRAIN = false; static constexpr int MIN_VMEM = 16;

    bf16* RKVZ; bf16* MID;
    __device__ __forceinline__ void operator()(const A4 (&acc)[2][2][4][2], const pg8::Unit& u, int wr, int wc, int fr, int fq) const {
        if (u.pn < 64) {
            const int row0 = u.pm * 256 + wr * 64 + fr, col0 = (u.pn & 15) * 256 + wc * 32 + 8 * fq;
#pragma unroll
            for (int ai = 0; ai < 2; ++ai)
#pragma unroll
                for (int m = 0; m < 4; ++m) { bf16* rowp = RKVZ + (size_t)(row0 + ai * 128 + m * 16) * D + col0;
#pragma unroll
                    for (int bj = 0; bj < 2; ++bj) { const A4 v0 = acc[ai][bj][m][0], v1 = acc[ai][bj][m][1]; v4u w;
                        w.x = pg8::cvt_pk_bf16(v0[0], v0[1]); w.y = pg8::cvt_pk_bf16(v0[2], v0[3]); w.z = pg8::cvt_pk_bf16(v1[0], v1[1]); w.w = pg8::cvt_pk_bf16(v1[2], v1[3]);
                        __builtin_nontemporal_store(w, (v4u*)(rowp + bj * 128)); } }
        } else {
            const int g2 = u.pn - 64;
            const int row0 = (u.pm - (4 + g2) * NPAN) * 256 + wr * 64 + fr, col0 = wc * 32 + 8 * fq;
#pragma unroll
            for (int ai = 0; ai < 2; ++ai)
#pragma unroll
                for (int m = 0; m < 4; ++m)
#pragma unroll
                    for (int bj = 0; bj < 2; ++bj) { A4 v0 = acc[ai][bj][m][0], v1 = acc[ai][bj][m][1];
                        if (g2 == 0) { for (int e = 0; e < 4; ++e) { v0[e] = 1.f - 2.f * __builtin_amdgcn_rcpf(1.f + __expf(2.f * v0[e])); v1[e] = 1.f - 2.f * __builtin_amdgcn_rcpf(1.f + __expf(2.f * v1[e])); } }
                        v4u w; w.x = pg8::cvt_pk_bf16(v0[0], v0[1]); w.y = pg8::cvt_pk_bf16(v0[2], v0[3]); w.z = pg8::cvt_pk_bf16(v1[0], v1[1]); w.w = pg8::cvt_pk_bf16(v1[2], v1[3]);
                        *(v4u*)(MID + ((size_t)(g2 * 2 + bj) * M + row0 + ai * 128 + m * 16) * 128 + col0) = w; }
        }
    }
};
struct EpiP3 {
    static constexpr bool PERM = true, AFTER_DRAIN = false; static constexpr int MIN_VMEM = 16;

    bf16* LWIC; const float* w0; const float* a0;
    __device__ __forceinline__ void operator()(const A4 (&acc)[2][2][4][2], const pg8::Unit& u, int wr, int wc, int fr, int fq) const {
        const int gi = u.pn >> 4;
        const int row0 = u.pm * 256 + wr * 64 + fr, col0 = (u.pn & 15) * 256 + wc * 32 + 8 * fq;
        const float* bias = (gi < 2 ? w0 + gi * D : a0 + (gi - 2) * D) + col0; const float osc = gi < 2 ? -0.6065306597126334f : 1.f;
        A4 bv[2][2];
#pragma unroll
        for (int bj = 0; bj < 2; ++bj)
#pragma unroll
            for (int n = 0; n < 2; ++n) bv[bj][n] = *(const A4*)(bias + bj * 128 + 4 * n);
#pragma unroll
        for (int ai = 0; ai < 2; ++ai)
#pragma unroll
            for (int m = 0; m < 4; ++m) { bf16* rowp = LWIC + (size_t)(row0 + ai * 128 + m * 16) * D + col0;
#pragma unroll
                for (int bj = 0; bj < 2; ++bj) { A4 v0 = acc[ai][bj][m][0] + bv[bj][0], v1 = acc[ai][bj][m][1] + bv[bj][1];
                    for (int e = 0; e < 4; ++e) { v0[e] = osc * sigmoidf_(v0[e]); v1[e] = osc * sigmoidf_(v1[e]); }
                    v4u w; w.x = pg8::cvt_pk_bf16(v0[0], v0[1]); w.y = pg8::cvt_pk_bf16(v0[2], v0[3]); w.z = pg8::cvt_pk_bf16(v1[0], v1[1]); w.w = pg8::cvt_pk_bf16(v1[2], v1[3]);
                    *(v4u*)(rowp + bj * 128) = w; asm volatile("" ::: "memory"); }
                }
    }
};
template <bool SRC_BF16, bool OUT_BF16>
struct EpiRes {
    static constexpr bool PERM = true, AFTER_DRAIN = false; static constexpr int MIN_VMEM = 16;

    const void* srcC; const void* srcL;
    void* out; const float* mod;
    __device__ __forceinline__ void operator()(const A4 (&acc)[2][2][4][2], const pg8::Unit& u, int wr, int wc, int fr, int fq) const {
        const int row0 = u.pm * 256 + wr * 64 + fr, col0 = u.pn * 256 + wc * 32 + 8 * fq;
        const int j = u.pm < 32 ? 0 : 1 + ((u.pm - 32) >> 2);
        const float* gate = mod + (size_t)j * 12288 + 2 * D + col0;
        const size_t srow = u.pm < 32 ? (size_t)row0 : (size_t)(row0 - MC);
        const void* sbase = u.pm < 32 ? srcC : srcL;
        A4 gv[2][2];
#pragma unroll
        for (int bj = 0; bj < 2; ++bj)
#pragma unroll
            for (int n = 0; n < 2; ++n) gv[bj][n] = *(const A4*)(gate + bj * 128 + 4 * n);
#pragma unroll
        for (int ai = 0; ai < 2; ++ai)
#pragma unroll
            for (int m = 0; m < 4; ++m) { const size_t so = (srow + ai * 128 + m * 16) * D + col0, od = (size_t)(row0 + ai * 128 + m * 16) * D + col0;
#pragma unroll
                for (int bj = 0; bj < 2; ++bj) {
                    f32x4 xa, xb;
                    if (SRC_BF16) bf8(*(const v4u*)((const bf16*)sbase + so + bj * 128), xa, xb);
                    else { xa = *(const f32x4*)((const float*)sbase + so + bj * 128); xb = *(const f32x4*)((const float*)sbase + so + bj * 128 + 4); }
                    const A4 a0 = acc[ai][bj][m][0], a1 = acc[ai][bj][m][1]; const A4 g0 = gv[bj][0], g1 = gv[bj][1];
                    const f32x4 oa = xa + (f32x4){g0[0] * a0[0], g0[1] * a0[1], g0[2] * a0[2], g0[3] * a0[3]}, ob = xb + (f32x4){g1[0] * a1[0], g1[1] * a1[1], g1[2] * a1[2], g1[3] * a1[3]};
                    if (OUT_BF16) *(v4u*)((bf16*)out + od + bj * 128) = pk8(oa, ob);
                    else { *(f32x4*)((float*)out + od + bj * 128) = oa; *(f32x4*)((float*)out + od + bj * 128 + 4) = ob; }
                } }
    }
};
struct EpiP8 {
    static constexpr bool PERM = true, AFTER_DRAIN = false; static constexpr int MIN_VMEM = 16;

    bf16* QKVZ; float* AB;
    __device__ __forceinline__ void operator()(const A4 (&acc)[2][2][4][2], const pg8::Unit& u, int wr, int wc, int fr, int fq) const {
        const int row0 = u.pm * 256 + wr * 64 + fr;
        if (u.pn < 64) {
            const int col0 = u.pn * 256 + wc * 32 + 8 * fq;
#pragma unroll
            for (int ai = 0; ai < 2; ++ai)
#pragma unroll
                for (int m = 0; m < 4; ++m) { bf16* rowp = QKVZ + (size_t)(row0 + ai * 128 + m * 16) * 16384 + col0;
#pragma unroll
                    for (int bj = 0; bj < 2; ++bj) { const A4 v0 = acc[ai][bj][m][0], v1 = acc[ai][bj][m][1]; v4u w;
                        w.x = pg8::cvt_pk_bf16(v0[0], v0[1]); w.y = pg8::cvt_pk_bf16(v0[2], v0[3]); w.z = pg8::cvt_pk_bf16(v1[0], v1[1]); w.w = pg8::cvt_pk_bf16(v1[2], v1[3]);
                        __builtin_nontemporal_store(w, (v4u*)(rowp + bj * 128)); } }
        } else {
            const int col0 = wc * 32 + 8 * fq; float* ABq = AB + (size_t)(u.k0 >> 10) * M * 128;
#pragma unroll
            for (int ai = 0; ai < 2; ++ai)
#pragma unroll
                for (int m = 0; m < 4; ++m) { float* rowp = ABq + (size_t)(row0 + ai * 128 + m * 16) * 128 + col0;
                    *(A4*)(rowp) = acc[ai][0][m][0]; *(A4*)(rowp + 4) = acc[ai][0][m][1]; }
        }
    }
};

__device__ __forceinline__ const float* xrow(const float* xp, const float* xs, int m) { return m < MC ? xp + (size_t)m * D : xs + (size_t)(m - MC) * D; }
__device__ __forceinline__ float red16(float v) { v += __shfl_xor(v, 1); v += __shfl_xor(v, 2); v += __shfl_xor(v, 4); v += __shfl_xor(v, 8); return v; }
__device__ __forceinline__ float red32(float v) { v = red16(v); v += __shfl_xor(v, 16); return v; }
__device__ __forceinline__ float sum4(f32x4 v) { return (v.x + v.y) + (v.z + v.w); }

__device__ __forceinline__ void p0_mod(LAS unsigned char* lds, const float* c, const float* c_ctx, const float* ada_w, const float* ada_b, float* MOD, int tid, int lane, int wave, int G) {
    LAS float* tab = (LAS float*)lds;
    LAS float* red = (LAS float*)(lds + 81920);
    for (int i = tid; i < 5 * D; i += NWAVES * 64) { const int j = i / D, k = i % D; const float cv = (j == 0) ? c_ctx[k] : c[(j - 1) * D + k]; tab[i] = siluf_(cv); }
    __syncthreads();
    for (int item = blockIdx.x; item < 192; item += G) {
        const int L = item / 96, cb = item % 96, half = lane >> 5;
        const float* W = ada_w + (size_t)L * D * 12288 + cb * 128 + (lane & 31) * 4;
        f32x4 acc[5];
#pragma unroll
        for (int j = 0; j < 5; ++j) acc[j] = (f32x4){0.f, 0.f, 0.f, 0.f};
        const int kb = wave * 512 + half;
#pragma unroll 8
        for (int kk = 0; kk < 256; ++kk) { const int k = kb + 2 * kk; const f32x4 w = __builtin_nontemporal_load((const f32x4*)(W + (size_t)k * 12288));
#pragma unroll
            for (int j = 0; j < 5; ++j) acc[j] += tab[j * D + k] * w; }
#pragma unroll
        for (int j = 0; j < 5; ++j) { acc[j].x += __shfl_xor(acc[j].x, 32); acc[j].y += __shfl_xor(acc[j].y, 32); acc[j].z += __shfl_xor(acc[j].z, 32); acc[j].w += __shfl_xor(acc[j].w, 32); }
        if (half == 0) {
#pragma unroll
            for (int j = 0; j < 5; ++j) *(LAS f32x4*)(red + (wave * 5 + j) * 128 + (lane & 31) * 4) = acc[j];
        }
        __syncthreads();
        for (int i = tid; i < 640; i += NWAVES * 64) { const int j = i / 128, col = i % 128; float s = 0.f;
#pragma unroll
            for (int w = 0; w < 8; ++w) s += red[(w * 5 + j) * 128 + col];
            const int gc = cb * 128 + col; MOD[(size_t)(L * 5 + j) * 12288 + gc] = s + ada_b[(size_t)L * 12288 + gc]; }
        __syncthreads();
    }
    __syncthreads();
}
__device__ __forceinline__ void rstd_rows(const float* xp, const float* xs, float* RSTD, int gw, int NGW, int lane) {
    for (int m = gw; m < M; m += NGW) { const f32x4* xr = (const f32x4*)xrow(xp, xs, m) + lane; float s = 0.f;
#pragma unroll
        for (int j = 0; j < 16; ++j) { const f32x4 v = xr[64 * j]; s += (v.x * v.x + v.y * v.y) + (v.z * v.z + v.w * v.w); }
        s = wave_sum(s); if (lane == 0) RSTD[m] = rsqrtf(s * (1.f / D) + 1e-6f); }
}
__device__ __forceinline__ int p1_nbr(int m, int q, int& j) {
    if (m < MC) { const int t = m & 255; j = 0; return (q < 2) ? (t > 0 ? m - 1 : -1) : (t < 255 ? m + 1 : -1); }
    const int ml = m - MC, t = ml & 1023, gc = t & 63, gr = t >> 6; j = 1 + (ml >> 10);
    return q == 0 ? (gc > 0 ? m - 1 : -1) : (q == 1 ? (gc < 63 ? m + 1 : -1) : (q == 2 ? (gr > 0 ? m - 64 : -1) : (gr < 15 ? m + 64 : -1)));
}
__device__ __forceinline__ void p1_mix(const float* xp, const float* xs, const float* RSTD, const float* mod0, const float* nw, const float* mu, bf16* XMIX, int gw, int NGW, int lane) {
    const f32x4 z4 = (f32x4){0.f, 0.f, 0.f, 0.f};
    for (int task = gw; task < 2048; task += NGW) {
        const int it = task & 7, rg = task >> 3, c = it * 512 + lane * 8, q = it >> 1, m0 = rg * 48;
        const f32x4 nwa = *(const f32x4*)(nw + c), nwb = *(const f32x4*)(nw + c + 4); f32x4 mua[6], mub[6];
#pragma unroll
        for (int p = 0; p < 6; ++p) { mua[p] = *(const f32x4*)(mu + p * D + c); mub[p] = *(const f32x4*)(mu + p * D + c + 4); }
        f32x4 XA[4], XB[4], NA[4], NB[4];
#pragma unroll
        for (int r = 0; r < 4; ++r) { const int m = m0 + r; int j; const int n = p1_nbr(m, q, j); const float* xr = xrow(xp, xs, m) + c; XA[r] = *(const f32x4*)xr; XB[r] = *(const f32x4*)(xr + 4);
            NA[r] = z4; NB[r] = z4; if (n >= 0) { const float* xn = xrow(xp, xs, n) + c; NA[r] = *(const f32x4*)xn; NB[r] = *(const f32x4*)(xn + 4); } }
#pragma unroll 1
        for (int b = 0; b < 12; ++b) {
            f32x4 PXA[4], PXB[4], PNA[4], PNB[4];
#pragma unroll
            for (int r = 0; r < 4; ++r) { PXA[r] = z4; PXB[r] = z4; PNA[r] = z4; PNB[r] = z4;
                if (b < 11) { const int m = m0 + 4 * (b + 1) + r; int j; const int n = p1_nbr(m, q, j); const float* xr = xrow(xp, xs, m) + c; PXA[r] = *(const f32x4*)xr; PXB[r] = *(const f32x4*)(xr + 4);
                    if (n >= 0) { const float* xn = xrow(xp, xs, n) + c; PNA[r] = *(const f32x4*)xn; PNB[r] = *(const f32x4*)(xn + 4); } } }
#pragma unroll
            for (int r = 0; r < 4; ++r) {
                const int m = m0 + 4 * b + r; int j; const int n = p1_nbr(m, q, j);
                const float* sh = mod0 + (size_t)j * 12288 + c; const float* sc = sh + D; const float rs = RSTD[m];
                const f32x4 aa = nwa * (1.f + *(const f32x4*)sc), ab = nwb * (1.f + *(const f32x4*)(sc + 4)), sa = *(const f32x4*)sh, sb = *(const f32x4*)(sh + 4);
                const f32x4 ha = XA[r] * rs * aa + sa, hb = XB[r] * rs * ab + sb; f32x4 hsa = z4, hsb = z4;
                if (n >= 0) { const float rn = RSTD[n]; hsa = NA[r] * rn * aa + sa; hsb = NB[r] * rn * ab + sb; }
                const f32x4 xa = hsa - ha, xb = hsb - hb;
#pragma unroll
                for (int p = 0; p < 6; ++p) *(v4u*)(XMIX + ((size_t)p * M + m) * D + c) = pk8(ha + xa * mua[p], hb + xb * mub[p]);
            }
#pragma unroll
            for (int r = 0; r < 4; ++r) { XA[r] = PXA[r]; XB[r] = PXB[r]; NA[r] = PNA[r]; NB[r] = PNB[r]; }
        }
    }
}
__device__ __forceinline__ void rwkv_seq(LAS float* wl, int lane, int row0, int T, int h, int d, const bf16* RKVZ, const bf16* LWIC, const float* k_k, const float* k_a,
                                         const float* sinit, float* sfin, float* Yd) {
    float S[64];
    if (sinit) {
#pragma unroll
        for (int k4 = 0; k4 < 16; ++k4) { const f32x4 v = *(const f32x4*)(sinit + lane * 64 + 4 * k4); S[4 * k4] = v.x; S[4 * k4 + 1] = v.y; S[4 * k4 + 2] = v.z; S[4 * k4 + 3] = v.w; }
    } else {
#pragma unroll
        for (int k = 0; k < 64; ++k) S[k] = 0.f;
    }
    const int c = h * 64 + lane; const float kkc = k_k[c], kac = k_a[c];
#pragma unroll 1
    for (int t0 = 0; t0 < T; t0 += 8) {
#pragma unroll
        for (int i = 0; i < 8; ++i) {
            const int tt = t0 + i, t = d ? (T - 1 - tt) : tt; const size_t row = (size_t)(row0 + t);
            const float rf = bf2f(RKVZ[((size_t)0 * M + row) * D + c]), kf = bf2f(RKVZ[((size_t)1 * M + row) * D + c]), vf = bf2f(RKVZ[((size_t)2 * M + row) * D + c]);
            const float lw = bf2f(LWIC[((size_t)d * M + row) * D + c]), ic = bf2f(LWIC[((size_t)(2 + d) * M + row) * D + c]);
            const float kkv = kf * kkc; const float nrm = wave_sum(kkv * kkv); const float kk = kkv * rsqrtf(nrm + 1e-6f);
            LAS float* p = wl + i * 384;
            p[lane] = __expf(lw); p[64 + lane] = kk; p[128 + lane] = kk * ic; p[192 + lane] = kf * (1.f + (ic - 1.f) * kac); p[256 + lane] = rf; p[320 + lane] = vf;
        }
        LDS_WAIT();
#pragma unroll 1
        for (int i = 0; i < 8; ++i) {
            const LAS f32x4* W4 = (const LAS f32x4*)(wl + i * 384); const LAS f32x4* KK4 = W4 + 16; const LAS f32x4* B4 = W4 + 32; const LAS f32x4* KT4 = W4 + 48; const LAS f32x4* R4 = W4 + 64;
            const float vv = wl[i * 384 + 320 + lane];
            float d0 = 0.f, d1 = 0.f, d2 = 0.f, d3 = 0.f;
#pragma unroll
            for (int k4 = 0; k4 < 16; ++k4) { const f32x4 q = KK4[k4]; d0 += S[4 * k4] * q.x; d1 += S[4 * k4 + 1] * q.y; d2 += S[4 * k4 + 2] * q.z; d3 += S[4 * k4 + 3] * q.w; }
            const float dot = (d0 + d1) + (d2 + d3);
            float y0 = 0.f, y1 = 0.f, y2 = 0.f, y3 = 0.f;
#pragma unroll
            for (int k4 = 0; k4 < 16; ++k4) { const f32x4 w4 = W4[k4], b4 = B4[k4], t4 = KT4[k4], r4 = R4[k4];
                float s;
                s = S[4 * k4] * w4.x + (vv * t4.x - dot * b4.x); S[4 * k4] = s; y0 += s * r4.x;
                s = S[4 * k4 + 1] * w4.y + (vv * t4.y - dot * b4.y); S[4 * k4 + 1] = s; y1 += s * r4.y;
                s = S[4 * k4 + 2] * w4.z + (vv * t4.z - dot * b4.z); S[4 * k4 + 2] = s; y2 += s * r4.z;
                s = S[4 * k4 + 3] * w4.w + (vv * t4.w - dot * b4.w); S[4 * k4 + 3] = s; y3 += s * r4.w; }
            const int tt = t0 + i, t = d ? (T - 1 - tt) : tt;
            Yd[(size_t)(row0 + t) * D + c] = (y0 + y1) + (y2 + y3);
        }
    }
    if (sfin) {
#pragma unroll
        for (int k4 = 0; k4 < 16; ++k4) *(f32x4*)(sfin + lane * 64 + 4 * k4) = (f32x4){S[4 * k4], S[4 * k4 + 1], S[4 * k4 + 2], S[4 * k4 + 3]};
    }
}
__device__ __forceinline__ void p5_post(const bf16* YF, const bf16* YB, const bf16* RKVZ, const bf16* LWIC, const float* ln_w, const float* ln_b, const float* k_a, const float* r_k, bf16* Gout, int gw, int NGW, int lane) {
    for (int task = gw; task < 2048; task += NGW) {
        const int it = task & 7, rg = task >> 3, c = it * 512 + lane * 8;
        const f32x4 lwa = *(const f32x4*)(ln_w + c), lwb = *(const f32x4*)(ln_w + c + 4), lba = *(const f32x4*)(ln_b + c), lbb = *(const f32x4*)(ln_b + c + 4);
        const f32x4 kaa = *(const f32x4*)(k_a + c), kab = *(const f32x4*)(k_a + c + 4), r0a = *(const f32x4*)(r_k + c), r0b = *(const f32x4*)(r_k + c + 4), r1a = *(const f32x4*)(r_k + D + c), r1b = *(const f32x4*)(r_k + D + c + 4);
        v4u cur[2][8], nxt[2][8];
#define NTL(p_) __builtin_nontemporal_load((const v4u*)(p_))
#define P5_LOAD(dst, m_) do { const size_t o_ = (size_t)(m_) * D + c; dst[0] = NTL(YF + o_); dst[1] = NTL(YB + o_); dst[2] = NTL(RKVZ + o_); dst[3] = NTL(RKVZ + (size_t)M * D + o_); \
            dst[4] = NTL(RKVZ + (size_t)2 * M * D + o_); dst[5] = NTL(RKVZ + (size_t)3 * M * D + o_); dst[6] = NTL(LWIC + (size_t)2 * M * D + o_); dst[7] = NTL(LWIC + (size_t)3 * M * D + o_); } while (0)
        P5_LOAD(cur[0], rg * 48); P5_LOAD(cur[1], rg * 48 + 1);
#pragma unroll 1
        for (int b = 0; b < 24; ++b) {
            const int mn = rg * 48 + 2 * (b + 1) < M - 1 ? rg * 48 + 2 * (b + 1) : M - 2;
            P5_LOAD(nxt[0], mn); P5_LOAD(nxt[1], mn + 1);
#pragma unroll
            for (int r = 0; r < 2; ++r) {
                const int m = rg * 48 + 2 * b + r; const size_t o = (size_t)m * D + c;
                f32x4 ya, yb, ta, tb; bf8(cur[r][0], ya, yb); bf8(cur[r][1], ta, tb); ya = ya + ta; yb = yb + tb;
                const float mean = red8(sum4(ya) + sum4(yb)) * (1.f / 64.f); const f32x4 da = ya - mean, db = yb - mean;
                const float var = red8(sum4(da * da) + sum4(db * db)) * (1.f / 64.f); const float rinv = rsqrtf(var + 64e-5f);
                const f32x4 yna = da * rinv * lwa + lba, ynb = db * rinv * lwb + lbb;
                f32x4 ra, rb, ka, kb, va, vb, za, zb, i0a, i0b, i1a, i1b;
                bf8(cur[r][2], ra, rb); bf8(cur[r][3], ka, kb); bf8(cur[r][4], va, vb); bf8(cur[r][5], za, zb); bf8(cur[r][6], i0a, i0b); bf8(cur[r][7], i1a, i1b);
                const f32x4 t0a = ka * (1.f + (i0a - 1.f) * kaa), t0b = kb * (1.f + (i0b - 1.f) * kab), t1a = ka * (1.f + (i1a - 1.f) * kaa), t1b = kb * (1.f + (i1b - 1.f) * kab);
                const float bonus = red8(sum4(ra * (t0a * r0a + t1a * r1a)) + sum4(rb * (t0b * r0b + t1b * r1b)));
                *(v4u*)(Gout + o) = pk8((yna + bonus * va) * silu4(za), (ynb + bonus * vb) * silu4(zb));
            }
#pragma unroll
            for (int r = 0; r < 2; ++r)
#pragma unroll
                for (int k = 0; k < 8; ++k) cur[r][k] = nxt[r][k];
        }
#undef P5_LOAD
#undef NTL
    }
}
__device__ __forceinline__ void p7_norm(const float* X1, const float* mod1, const float* nw, bf16* H1, int gw, int NGW, int lane) {
    for (int m = gw; m < M; m += NGW) {
        const int j = m < MC ? 0 : 1 + ((m - MC) >> 10); const float* sh = mod1 + (size_t)j * 12288; const float* sc = sh + D;
        const f32x4* xr = (const f32x4*)(X1 + (size_t)m * D) + lane; f32x4 v[16]; float s = 0.f;
#pragma unroll
        for (int jj = 0; jj < 16; ++jj) { v[jj] = xr[64 * jj]; s += sum4(v[jj] * v[jj]); }
        const float rs = rsqrtf(wave_sum(s) * (1.f / D) + 1e-6f);
#pragma unroll
        for (int jj = 0; jj < 16; ++jj) { const int c = jj * 256 + lane * 4; const f32x4 a4 = *(const f32x4*)(nw + c) * (1.f + *(const f32x4*)(sc + c));
            *(v2u*)(H1 + (size_t)m * D + c) = pk4(v[jj] * rs * a4 + *(const f32x4*)(sh + c)); }
    }
}
__device__ __forceinline__ void p9_prep(const bf16* QKVZ, const float* AB, const float* conv, const float* A_log, const float* dt_bias, bf16* QKVc, float* GB, int gw, int NGW, int lane) {
    for (int task = gw; task < 24 * 256; task += NGW) {
        const int it = task % 24, rg = task / 24, c = it * 512 + lane * 8;
        const f32x4 w0a = *(const f32x4*)(conv + c), w0b = *(const f32x4*)(conv + c + 4), w1a = *(const f32x4*)(conv + 12288 + c), w1b = *(const f32x4*)(conv + 12288 + c + 4), w2a = *(const f32x4*)(conv + 2 * 12288 + c), w2b = *(const f32x4*)(conv + 2 * 12288 + c + 4);
        const float qs = it < 8 ? 0.08838834764831845f : 1.f;
        const int m0 = rg * 48; const bf16* base = QKVZ + (size_t)(m0 - 1) * 16384 + c;
        v4u w[10];
#pragma unroll
        for (int j = 0; j < 10; ++j) { w[j] = (v4u){0u, 0u, 0u, 0u}; if (m0 - 1 + j >= 0 && m0 - 1 + j < M) w[j] = *(const v4u*)(base + (size_t)j * 16384); }
#pragma unroll 1
        for (int b = 0; b < 6; ++b) {
            v4u nx[8];
#pragma unroll
            for (int k = 0; k < 8; ++k) { const int j = 8 * b + 10 + k; nx[k] = (v4u){0u, 0u, 0u, 0u}; if (b < 5 && m0 - 1 + j < M) nx[k] = *(const v4u*)(base + (size_t)j * 16384); }
#pragma unroll
            for (int r = 0; r < 8; ++r) {
                const int m = m0 + 8 * b + r; int t, T; if (m < MC) { t = m & 255; T = 256; } else { t = (m - MC) & 1023; T = 1024; }
                f32x4 x1a, x1b, x0a, x0b, x2a, x2b; bf8(w[r + 1], x1a, x1b); bf8(w[r], x0a, x0b); bf8(w[r + 2], x2a, x2b);
                if (t == 0) { x0a = (f32x4){0.f, 0.f, 0.f, 0.f}; x0b = x0a; }
                if (t == T - 1) { x2a = (f32x4){0.f, 0.f, 0.f, 0.f}; x2b = x2a; }
                f32x4 ya = silu4(w0a * x0a + w1a * x1a + w2a * x2a), yb = silu4(w0b * x0b + w1b * x1b + w2b * x2b);
                if (it < 16) { const float ss = red16(sum4(ya * ya) + sum4(yb * yb)); const float scl = rsqrtf(ss + 1e-6f) * qs; ya = ya * scl; yb = yb * scl; }
                *(v4u*)(QKVc + (size_t)m * 12288 + c) = pk8(ya, yb);
            }
            w[0] = w[8]; w[1] = w[9];
#pragma unroll
            for (int k = 0; k < 8; ++k) w[2 + k] = nx[k];
        }
    }
    for (int m = gw; m < M; m += NGW) {
        const int dir = lane >> 5, hh = lane & 31; float a = 0.f, b = 0.f;
#pragma unroll
        for (int kq = 0; kq < 4; ++kq) { a += AB[((size_t)kq * M + m) * 128 + dir * 64 + hh]; b += AB[((size_t)kq * M + m) * 128 + dir * 64 + 32 + hh]; }
        GB[(size_t)m * 128 + dir * 64 + hh] = -__expf(A_log[dir * 32 + hh]) * softplusf_(a + dt_bias[dir * 32 + hh]);
        GB[(size_t)m * 128 + dir * 64 + 32 + hh] = sigmoidf_(b);
    }
}
__device__ __forceinline__ void gdn_seq(LAS float* wl, int lane, int row0, int T, int h, int d, int hv, const bf16* QKVc, const float* GB, const float* sinit, float* sfin, float* Od) {
    float S[128];
    const int vc = hv * 64 + lane;
    if (sinit) {
#pragma unroll
        for (int k = 0; k < 128; ++k) S[k] = sinit[k * 128 + vc];
    } else {
#pragma unroll
        for (int k = 0; k < 128; ++k) S[k] = 0.f;
    }
#pragma unroll 1
    for (int t0 = 0; t0 < T; t0 += 8) {
#pragma unroll
        for (int i = 0; i < 8; ++i) {
            const int tt = t0 + i, t = d ? (T - 1 - tt) : tt; const size_t row = (size_t)(row0 + t);
            const unsigned q2 = *(const unsigned*)(QKVc + row * 12288 + h * 128 + lane * 2), k2 = *(const unsigned*)(QKVc + row * 12288 + 4096 + h * 128 + lane * 2);
            const float vf = bf2f(QKVc[row * 12288 + 8192 + h * 128 + vc]);
            LAS float* p = wl + i * 384;
            p[2 * lane] = __builtin_bit_cast(float, q2 << 16); p[2 * lane + 1] = __builtin_bit_cast(float, q2 & 0xffff0000u);
            p[128 + 2 * lane] = __builtin_bit_cast(float, k2 << 16); p[128 + 2 * lane + 1] = __builtin_bit_cast(float, k2 & 0xffff0000u);
            p[256 + lane] = vf;
            if (lane == 0) { p[320] = __expf(GB[row * 128 + d * 64 + h]); p[321] = GB[row * 128 + d * 64 + 32 + h]; }
        }
        LDS_WAIT();
#pragma unroll 1
        for (int i = 0; i < 8; ++i) {
            const LAS f32x4* Q4 = (const LAS f32x4*)(wl + i * 384); const LAS f32x4* K4 = Q4 + 32;
            const float vv = wl[i * 384 + 256 + lane], a = wl[i * 384 + 320], beta = wl[i * 384 + 321];
            float d0 = 0.f, d1 = 0.f, d2 = 0.f, d3 = 0.f;
#pragma unroll
            for (int k4 = 0; k4 < 32; ++k4) { const f32x4 q = K4[k4]; d0 += S[4 * k4] * q.x; d1 += S[4 * k4 + 1] * q.y; d2 += S[4 * k4 + 2] * q.z; d3 += S[4 * k4 + 3] * q.w;
                if ((k4 & 7) == 7) asm volatile("" ::: "memory"); }
            const float dot = (d0 + d1) + (d2 + d3);
            const float cc = beta * (vv - a * dot);
            float y0 = 0.f, y1 = 0.f, y2 = 0.f, y3 = 0.f;
#pragma unroll
            for (int k4 = 0; k4 < 32; ++k4) { const f32x4 kq = K4[k4], qq = Q4[k4];
                float s;
                s = a * S[4 * k4] + cc * kq.x; S[4 * k4] = s; y0 += s * qq.x;
                s = a * S[4 * k4 + 1] + cc * kq.y; S[4 * k4 + 1] = s; y1 += s * qq.y;
                s = a * S[4 * k4 + 2] + cc * kq.z; S[4 * k4 + 2] = s; y2 += s * qq.z;
                s = a * S[4 * k4 + 3] + cc * kq.w; S[4 * k4 + 3] = s; y3 += s * qq.w;
                if ((k4 & 3) == 3) asm volatile("" ::: "memory"); }
            const int tt = t0 + i, t = d ? (T - 1 - tt) : tt;
            Od[(size_t)(row0 + t) * D + h * 128 + vc] = (y0 + y1) + (y2 + y3);
        }
    }
    if (sfin) {
#pragma unroll
        for (int k = 0; k < 128; ++k) sfin[k * 128 + vc] = S[k];
    }
}
__device__ __forceinline__ void p11_post(const bf16* OF, const bf16* OB, const bf16* QKVZ, const float* gnw, bf16* G2, int gw, int NGW, int lane) {
    for (int task = gw; task < 2048; task += NGW) {
        const int it = task & 7, rg = task >> 3, c = it * 512 + lane * 8;
        const f32x4 ga = *(const f32x4*)(gnw + (lane & 15) * 8), gb = *(const f32x4*)(gnw + (lane & 15) * 8 + 4);
#pragma unroll 4
        for (int r = 0; r < 48; ++r) {
            const int m = rg * 48 + r; const size_t o = (size_t)m * D + c;
            f32x4 ya, yb, ta, tb, za, zb; bf8(__builtin_nontemporal_load((const v4u*)(OF + o)), ya, yb); bf8(__builtin_nontemporal_load((const v4u*)(OB + o)), ta, tb); ya = ya + ta; yb = yb + tb;
            const float ms = red16(sum4(ya * ya) + sum4(yb * yb)) * (1.f / 128.f); const float rinv = rsqrtf(ms + 1e-6f);
            bf8(__builtin_nontemporal_load((const v4u*)(QKVZ + (size_t)m * 16384 + 12288 + c)), za, zb);
            *(v4u*)(G2 + o) = pk8(ya * rinv * ga * silu4(za), yb * rinv * gb * silu4(zb));
        }
    }
}
__device__ __forceinline__ void p13_final(float* Y, const float* fw, int gw, int NGW, int lane) {
    for (int m = gw; m < M; m += NGW) {
        f32x4* xr = (f32x4*)(Y + (size_t)m * D) + lane; f32x4 v[16]; float s = 0.f;
#pragma unroll
        for (int jj = 0; jj < 16; ++jj) { v[jj] = xr[64 * jj]; s += sum4(v[jj] * v[jj]); }
        const float rs = rsqrtf(wave_sum(s) * (1.f / D) + 1e-6f);
#pragma unroll
        for (int jj = 0; jj < 16; ++jj) xr[64 * jj] = v[jj] * rs * *(const f32x4*)(fw + jj * 256 + lane * 4);
    }
}

template <int MODE, bool IN_BF16 = false>
__device__ __forceinline__ void norm8_block(LAS unsigned char* lds, const float* xp, const float* xs, float* RSTD, const float* mod, const float* nw, bf16* H1, float* Yio, int bx, int G, int wave, int lane) {
    LAS float* red = (LAS float*)lds;
    const int c0 = wave * 512 + lane * 8, c1 = c0 + 4;
    f32x4 p0 = (f32x4){0.f, 0.f, 0.f, 0.f}, p1 = p0;
    if (MODE != 0) { p0 = *(const f32x4*)(nw + c0); p1 = *(const f32x4*)(nw + c1); }
    int par = 0;
    for (int grp = bx; grp < M / 8; grp += G, par ^= 1) {
        const int m0 = grp * 8;
        f32x4 v[8][2];
#pragma unroll
        for (int r = 0; r < 8; ++r) {
            if (IN_BF16) bf8(__builtin_nontemporal_load((const v4u*)((const bf16*)xp + (size_t)(m0 + r) * D + c0)), v[r][0], v[r][1]);
            else { const float* xr = (MODE == 2) ? Yio + (size_t)(m0 + r) * D : xrow(xp, xs, m0 + r); v[r][0] = *(const f32x4*)(xr + c0); v[r][1] = *(const f32x4*)(xr + c1); } }
#pragma unroll
        for (int r = 0; r < 8; ++r) { const float s = wave_sum_dpp(sum4(v[r][0] * v[r][0]) + sum4(v[r][1] * v[r][1])); if (lane == 0) red[(par * 8 + r) * 8 + wave] = s; }
        LDS_BAR();
        f32x4 a0 = p0, a1 = p1, s0 = (f32x4){0.f, 0.f, 0.f, 0.f}, s1 = s0;
        if (MODE == 1) { const int j = m0 < MC ? 0 : 1 + ((m0 - MC) >> 10); const float* sh = mod + (size_t)j * 12288; const float* sc = sh + D;
            a0 = p0 * (1.f + *(const f32x4*)(sc + c0)); a1 = p1 * (1.f + *(const f32x4*)(sc + c1)); s0 = *(const f32x4*)(sh + c0); s1 = *(const f32x4*)(sh + c1); }
#pragma unroll
        for (int r = 0; r < 8; ++r) {
            const LAS f32x4* rr = (const LAS f32x4*)(red + (par * 8 + r) * 8); const f32x4 ra = rr[0], rb = rr[1];
            const float rs = rsqrtf((sum4(ra) + sum4(rb)) * (1.f / D) + 1e-6f);
            if (MODE == 0) { if (wave == 0 && lane == 0) RSTD[m0 + r] = rs; }
            else if (MODE == 1) { bf16* o = H1 + (size_t)(m0 + r) * D; *(v4u*)(o + c0) = pk8(v[r][0] * rs * a0 + s0, v[r][1] * rs * a1 + s1); }
            else { float* o = Yio + (size_t)(m0 + r) * D; *(f32x4*)(o + c0) = v[r][0] * rs * a0; *(f32x4*)(o + c1) = v[r][1] * rs * a1; }
        }
    }
    LDS_BAR();
}

struct Args { const float* in[31]; float* out; unsigned char* ws; int ph_lo, ph_hi; };
__global__ void __launch_bounds__(NWAVES * 64, 2) mk_fwd(Args args) {
    extern __shared__ __attribute__((aligned(16))) unsigned char lds_raw[];
    LAS unsigned char* lds = (LAS unsigned char*)lds_raw;
    volatile LAS unsigned* MISC = (volatile LAS unsigned*)(lds + MISC_OFF);
    const int tid = threadIdx.x, lane = tid & 63, wave = __builtin_amdgcn_readfirstlane(tid >> 6);
    const int G = gridDim.x; const int bx = blockIdx.x;
    const int gw = bx * NWAVES + wave, NGW = G * NWAVES;
    unsigned char* ws = args.ws; float* out = args.out;
    gu32* ctl = (gu32*)(ws + WS_CTL);
    const float* x_prompt = args.in[0]; const float* x_sample = args.in[1]; const float* state_rwkv = args.in[2]; const float* state_gdn = args.in[3];
    const float* c_in = args.in[4]; const float* c_ctx = args.in[5]; const float* ada_w = args.in[6]; const float* ada_b = args.in[7];
    const float* norm_w = args.in[8]; const float* final_norm_w = args.in[9]; const float* rwkv_mu = args.in[10]; const float* rwkv_w_in = args.in[11];
    const float* rwkv_w0 = args.in[12]; const float* rwkv_w1 = args.in[13]; const float* rwkv_w2 = args.in[14]; const float* rwkv_a0 = args.in[15];
    const float* rwkv_a1 = args.in[16]; const float* rwkv_a2 = args.in[17]; const float* rwkv_k_k = args.in[18]; const float* rwkv_k_a = args.in[19];
    const float* rwkv_r_k = args.in[20]; const float* rwkv_ln_w = args.in[21]; const float* rwkv_ln_b = args.in[22]; const float* rwkv_w_out = args.in[23];
    const float* gdn_w_in = args.in[24]; const float* gdn_conv = args.in[25]; const float* gdn_w_ab = args.in[26]; const float* gdn_A_log = args.in[27];
    const float* gdn_dt_bias = args.in[28]; const float* gdn_norm_w = args.in[29]; const float* gdn_w_out = args.in[30];
    float* MOD = (float*)(ws + WS_MOD); float* RSTD = (float*)(ws + WS_RSTD); float* GB = (float*)(ws + WS_GB);
    bf16* WUP = (bf16*)(ws + WS_WUP); bf16* WIN = (bf16*)(ws + WS_WIN); bf16* WOUT = (bf16*)(ws + WS_WOUT);
    bf16* XMIX = (bf16*)(ws + WS_A); bf16* LWIC = (bf16*)(ws + WS_A); bf16* QKVZ = (bf16*)(ws + WS_A);
    bf16* RKVZ = (bf16*)(ws + WS_B); bf16* QKVc = (bf16*)(ws + WS_B); bf16* G2 = (bf16*)(ws + WS_B);
    float* YF = (float*)(ws + WS_C); float* YB = YF + (size_t)M * D;
    bf16* X1h = (bf16*)(ws + WS_A + 384 * MiB); bf16* X2h = (bf16*)(ws + WS_A + 480 * MiB);
    bf16* GOUT1 = (bf16*)(ws + WS_C + 224 * MiB);
    bf16* YFh = (bf16*)(ws + WS_C); bf16* YBh = YFh + (size_t)M * D;
    float* Y = out + O_Y; float* RS = out + O_RS; float* GS = out + O_GS;
    unsigned char* gsb = (unsigned char*)GS;
    bf16* Gb = (bf16*)(gsb + GS_G); bf16* MID = (bf16*)(gsb + GS_MID); float* AB = (float*)(ws + WS_C + 192 * MiB);

    for (int u = tid; u < (LDS_BYTES - LDSCTL_OFF) / 4; u += NWAVES * 64) ((LAS unsigned*)(lds + LDSCTL_OFF))[u] = 0u;
    __syncthreads();
    const int lo = args.ph_lo, hi = args.ph_hi;
    XcdBarrier bar; bar.bar = (unsigned*)(ctl + CW_BAR); bar.x = 0; bar.st = nullptr;
    if (hi - lo > 1) bar = xcd_barrier_post((unsigned*)(ctl + CW_BAR), MISC + 8);
#ifndef PHMASK
#define PHMASK 0xffffffffu
#endif
#define IN(k) (((PHMASK >> (k)) & 1u) && lo <= (k) && (k) < hi)
#ifndef DUPMASK
#define DUPMASK 0u
#endif
#define PH(k) if (IN(k)) for (int rep_ = 0; rep_ < ((((DUPMASK) >> (k)) & 1u) ? 2 : 1); ++rep_)
#define SEAM(k) do { if (IN(k) && IN((k) + 1)) xcd_barrier(bar); } while (0)

    PH(0) {
        p0_mod(lds, c_in, c_ctx, ada_w, ada_b, MOD, tid, lane, wave, G);
        LAS float* scr = (LAS float*)(lds + wave * 16384);
        constexpr int I_DD = 64 * 128, I_DN = 64 * 4, I_ND = 2 * 128;
        constexpr int NITEMS = 4 * I_DD + 4 * I_DN + 4 * I_ND + I_DD;
        for (int it = gw; it < NITEMS; it += NGW) {
            int r = it;
            if (r < 4 * I_DD) { const int p = r / I_DD; p0_transpose_item(rwkv_w_in + (size_t)p * D * D, D, D, WIN, p * D, scr, r % I_DD, lane); continue; } r -= 4 * I_DD;
            if (r < 2 * I_DN) { const int z = r / I_DN; p0_transpose_item(rwkv_w1 + (size_t)z * D * 128, D, 128, WIN, 16384 + z * 128, scr, r % I_DN, lane); continue; } r -= 2 * I_DN;
            if (r < 2 * I_DN) { const int z = r / I_DN; p0_transpose_item(rwkv_a1 + (size_t)z * D * 128, D, 128, WIN, 16640 + z * 128, scr, r % I_DN, lane); continue; } r -= 2 * I_DN;
            if (r < 2 * I_ND) { const int z = r / I_ND; p0_transpose_item(rwkv_w2 + (size_t)z * 128 * D, 128, D, WUP, z * D, scr, r % I_ND, lane); continue; } r -= 2 * I_ND;
            if (r < 2 * I_ND) { const int z = r / I_ND; p0_transpose_item(rwkv_a2 + (size_t)z * 128 * D, 128, D, WUP, (2 + z) * D, scr, r % I_ND, lane); continue; } r -= 2 * I_ND;
            p0_transpose_item(rwkv_w_out, D, D, WOUT, 0, scr, r, lane);
        }
        __syncthreads();
        norm8_block<0>(lds, x_prompt, x_sample, RSTD, nullptr, nullptr, nullptr, nullptr, bx, G, wave, lane);
    }
    SEAM(0);
    PH(1) p1_mix(x_prompt, x_sample, RSTD, MOD, norm_w, rwkv_mu, XMIX, gw, NGW, lane);
    SEAM(1);
    PH(2) {
        pg8::Gemm g{XMIX, WIN, 6 * M, 16896, D};
        MultiOrder S{G, bx, 4, 16, NPAN, 16, 2, 4 * NPAN, 64, 64, 1};
        EpiP2 E{RKVZ, MID};
        pg8::gemm_phase<EpiP2, MultiOrder, true, true>(lds, g, S, E);
    }
    SEAM(2);
    PH(3) {
        int k3 = 128; asm volatile("" : "+s"(k3));
        pg8::Gemm g{MID, WUP, 4 * M, 4 * D, k3};
        MultiOrder S{G, bx, 4, 16, NPAN, 16, 0, 0, 0, k3 / 64, 1};
        EpiP3 E{LWIC, rwkv_w0, rwkv_a0};
        pg8::gemm_phase<EpiP3, MultiOrder, true, true>(lds, g, S, E);
    }
    SEAM(3);
    PH(4) {
#if defined(RWKV_SEQ)
        LAS float* wl = (LAS float*)(lds + wave * 12288);
        if (wave < 2) {
            for (int lt = bx * 2 + wave; lt < 512; lt += 2 * G) { const int bl = lt >> 7, rem = lt & 127, h = rem >> 1, d = rem & 1;
                rwkv_seq(wl, lane, MC + bl * 1024, 1024, h, d, RKVZ, LWIC, rwkv_k_k, rwkv_k_a, state_rwkv + ((size_t)(bl * 2 + d) * 64 + h) * 4096, nullptr, d ? YB : YF); }
        } else {
            for (int ct = bx * 6 + wave - 2; ct < 4096; ct += 6 * G) { const int b = ct >> 7, rem = ct & 127, h = rem >> 1, d = rem & 1;
                rwkv_seq(wl, lane, b * 256, 256, h, d, RKVZ, LWIC, rwkv_k_k, rwkv_k_a, nullptr, RS + ((size_t)(b * 2 + d) * 64 + h) * 4096, d ? YB : YF); }
        }
#else
        rwkv_chunk_phase(lds, tid, lane, wave, bx, G, RKVZ, LWIC, rwkv_k_k, rwkv_k_a, state_rwkv, RS, YFh, YBh, gdn_w_in, gdn_w_ab, gdn_w_out, WIN, GOUT1);
#endif
    }
    SEAM(4);
    PH(5) p5_post(YFh, YBh, RKVZ, LWIC, rwkv_ln_w, rwkv_ln_b, rwkv_k_a, rwkv_r_k, Gb, gw, NGW, lane);
    SEAM(5);
    PH(6) {
        pg8::Gemm g{Gb, WOUT, M, D, D};
        MultiOrder S{G, bx, 1, 16, 0, 0, 0, 0, 0, 64, 1};
        EpiRes<false, true> E{x_prompt, x_sample, X1h, MOD};
        pg8::gemm_phase<EpiRes<false, true>, MultiOrder, true, true>(lds, g, S, E);
    }
    SEAM(6);
    PH(7) {
        norm8_block<1, true>(lds, (const float*)X1h, nullptr, nullptr, MOD + 5 * 12288, norm_w + D, Gb, nullptr, bx, G, wave, lane);
    }
    SEAM(7);
    PH(8) {
        pg8::Gemm g{Gb, WIN, M, 16640, D};
        MultiOrder S{G, bx, 1, 64, 0, 0, 1, 0, 64, 64, 4};
        EpiP8 E{QKVZ, AB};
        pg8::gemm_phase<EpiP8, MultiOrder, true, true>(lds, g, S, E);
    }
    SEAM(8);
    PH(9) p9_prep(QKVZ, AB, gdn_conv, gdn_A_log, gdn_dt_bias, QKVc, GB, gw, NGW, lane);
    SEAM(9);
    PH(10) {
#if defined(GDN_SEQ)
        LAS float* wl = (LAS float*)(lds + wave * 12288);
        float* OFb = YF; float* OBb = YB;
        if (wave < 2) {
            for (int lt = bx * 2 + wave; lt < 512; lt += 2 * G) { const int bl = lt >> 7, rem = lt & 127, h = rem >> 2, d = (rem >> 1) & 1, hv = rem & 1;
                gdn_seq(wl, lane, MC + bl * 1024, 1024, h, d, hv, QKVc, GB, state_gdn + ((size_t)(bl * 2 + d) * 32 + h) * 16384, nullptr, d ? OBb : OFb); }
        } else {
            for (int ct = bx * 6 + wave - 2; ct < 4096; ct += 6 * G) { const int b = ct >> 7, rem = ct & 127, h = rem >> 2, d = (rem >> 1) & 1, hv = rem & 1;
                gdn_seq(wl, lane, b * 256, 256, h, d, hv, QKVc, GB, nullptr, GS + ((size_t)(b * 2 + d) * 32 + h) * 16384, d ? OBb : OFb); }
        }
#else
        gdn_chunk_phase(lds, tid, lane, wave, bx, G, QKVc, GB, state_gdn, GS, YFh, YBh);
#endif
    }
    SEAM(10);
    PH(11) p11_post(YFh, YBh, QKVZ, gdn_norm_w, G2, gw, NGW, lane);
    SEAM(11);
    PH(12) {
        pg8::Gemm g{G2, GOUT1, M, D, D};
        MultiOrder S{G, bx, 1, 16, 0, 0, 0, 0, 0, 64, 1};
        EpiRes<true, true> E{X1h, X1h + (size_t)MC * D, X2h, MOD + 5 * 12288};
        pg8::gemm_phase<EpiRes<true, true>, MultiOrder, true, true>(lds, g, S, E);
    }
    SEAM(12);
    PH(13) norm8_block<2, true>(lds, (const float*)X2h, nullptr, nullptr, nullptr, final_norm_w, nullptr, Y, bx, G, wave, lane);
#undef IN
#undef SEAM
}

extern "C" void kernel_launch(void* const* d_in, const int* in_sizes, int n_in, void* d_out, int out_size, void* d_ws, size_t ws_size, hipStream_t stream) {
    static int grid = 0;
    if (grid == 0) {
        if (n_in != 31 || (size_t)out_size != O_END || ws_size < WS_END) { fprintf(stderr, "kernel_launch: unexpected shapes: n_in %d out %d ws %zu\n", n_in, out_size, ws_size); grid = -1; return; }
        int dev = 0, cus = 0, per_cu = 0;
        if (hipGetDevice(&dev) != hipSuccess || hipDeviceGetAttribute(&cus, hipDeviceAttributeMultiprocessorCount, dev) != hipSuccess) { grid = -1; return; }
        if (hipFuncSetAttribute((const void*)mk_fwd, hipFuncAttributeMaxDynamicSharedMemorySize, LDS_BYTES) != hipSuccess) { fprintf(stderr, "kernel_launch: hipFuncSetAttribute failed\n"); grid = -1; return; }
        if (hipOccupancyMaxActiveBlocksPerMultiprocessor(&per_cu, (const void*)mk_fwd, NWAVES * 64, LDS_BYTES) != hipSuccess || per_cu < 1) fprintf(stderr, "kernel_launch: occupancy query says %d\n", per_cu);
        (void)hipGetLastError();
        grid = cus;
    }
    if (grid < 0) return;
    if (hipMemsetAsync((char*)d_ws + WS_CTL, 0, CTL_ZERO_BYTES, stream) != hipSuccess) return;
    Args a{};
    for (int i = 0; i < 31; ++i) a.in[i] = (const float*)d_in[i];
    a.out = (float*)d_out; a.ws = (unsigned char*)d_ws;
#if MK_ONE_LAUNCH
    a.ph_lo = 0; a.ph_hi = NPH;
    hipLaunchKernelGGL(mk_fwd, dim3(grid), dim3(NWAVES * 64), LDS_BYTES, stream, a);
#else
    for (int p = 0; p < NPH; ++p) { a.ph_lo = p; a.ph_hi = p + 1; hipLaunchKernelGGL(mk_fwd, dim3(grid), dim3(NWAVES * 64), LDS_BYTES, stream, a); }
#endif
}
```

```cpp
#include <hip/hip_runtime.h>
#include <cstdio>
#include <cstdint>
namespace pg8 {
#define PG8_LAS __attribute__((address_space(3)))
typedef unsigned short bf16_t;
typedef short bf16x8 __attribute__((ext_vector_type(8)));
typedef float f32x4 __attribute__((ext_vector_type(4)));
typedef unsigned u32x4 __attribute__((ext_vector_type(4)));
constexpr int BM = 256, BK = 64, HALF = 128, HTB = HALF * BK * 2  , STAGE_BYTES = 8 * HTB, NXCD = 8, WGM = 8;

__host__ __device__ __forceinline__ int lds_byte(int r, int c) { const int st = (r >> 4) * 2 + (c >> 5), rr = r & 15, cc = c & 31, ob = rr * 64 + cc * 2; return st * 1024 + (ob ^ (((ob >> 9) & 1) << 5)); }
__host__ __device__ __forceinline__ void stage_rc(int b, int& R, int& C) { const int st = b / 1024, sb = b % 1024, swz = sb ^ (((sb >> 9) & 1) << 5); R = (st >> 1) * 16 + swz / 64; C = (st & 1) * 32 + (swz % 64) / 2; }
__host__ __device__ __forceinline__ int perm32(int rho) { const int n = rho >> 4, i = rho & 15; return 8 * (i >> 2) + 4 * n + (i & 3); }

struct Unit { int pm, pn, k0, nt; };
struct Gemm { const bf16_t* A; const bf16_t* Bt; int M, N, K; };

__device__ __forceinline__ unsigned cvt_pk_bf16(float lo, float hi) { unsigned r; asm volatile("v_cvt_pk_bf16_f32 %0, %1, %2" : "=v"(r) : "v"(lo), "v"(hi)); return r; }

template <class Epi, class Sched, bool ALIGN_EPI = false, bool SP2 = false>
__device__ __forceinline__ void gemm_phase(PG8_LAS unsigned char* lds, const Gemm g, const Sched& S, const Epi& E) {
    const int tid = threadIdx.x, wid = __builtin_amdgcn_readfirstlane(tid >> 6), lane = tid & 63, wr = wid >> 2, wc = wid & 3, fr = lane & 15, fq = lane >> 4;
    const int K = g.K;
    unsigned voffA[2], voffB[2];
#pragma unroll
    for (int i = 0; i < 2; ++i) { int R, C; stage_rc(tid * 16 + i * 8192, R, C); const int Rb = Epi::PERM ? ((R & ~31) + perm32(R & 31)) : R;
        voffA[i] = (unsigned)(R * K + C) * 2u; voffB[i] = (unsigned)(Rb * K + C) * 2u; }
    const size_t kstep = (size_t)(BK * 2);
    const size_t hstep = (size_t)HALF * K * 2;
    const size_t tstep = 2 * hstep;
    const unsigned ldsw = (unsigned)wid * 1024u;
    const int aoff = lds_byte(wr * 64 + fr, fq * 8), boff = lds_byte(wc * 32 + fr, fq * 8);
#define PG8_SA(b, h) (((b) * 2 + (h)) * HTB)
#define PG8_SB(b, h) ((4 + (b) * 2 + (h)) * HTB)
#define PG8_STAGE(bufoff, gbase, voff) do { _Pragma("unroll") for (int _i = 0; _i < 2; ++_i) \
        __builtin_amdgcn_global_load_lds((const unsigned*)((const char*)(gbase) + (voff)[_i]), (PG8_LAS unsigned*)(lds + (bufoff) + ldsw + _i * 8192), 16, 0, 0); } while (0)
#define PG8_LDA(dst, b, h) do { _Pragma("unroll") for (int m = 0; m < 4; ++m) _Pragma("unroll") for (int k = 0; k < 2; ++k) dst[m][k] = *(const PG8_LAS bf16x8*)(lds + PG8_SA(b, h) + aoff + m * 2048 + k * 1024); } while (0)
#define PG8_LDB(dst, b, h) do { _Pragma("unroll") for (int n = 0; n < 2; ++n) _Pragma("unroll") for (int k = 0; k < 2; ++k) dst[n][k] = *(const PG8_LAS bf16x8*)(lds + PG8_SB(b, h) + boff + n * 2048 + k * 1024); } while (0)
#define PG8_MMA(ai, bj, At, Bt) do { __builtin_amdgcn_s_setprio(1); _Pragma("unroll") for (int m = 0; m < 4; ++m) _Pragma("unroll") for (int n = 0; n < 2; ++n) _Pragma("unroll") for (int k = 0; k < 2; ++k) \
        acc[ai][bj][m][n] = __builtin_amdgcn_mfma_f32_16x16x32_bf16(Bt[n][k], At[m][k], acc[ai][bj][m][n], 0, 0, 0); __builtin_amdgcn_s_setprio(0); } while (0)
#define PG8_WAIT_V(n) asm volatile("s_waitcnt vmcnt(" #n ")" ::: "memory")
#define PG8_WAIT_L(n) asm volatile("s_waitcnt lgkmcnt(" #n ")" ::: "memory")
#define PG8_BAR __builtin_amdgcn_s_barrier()
#define PG8_SCHED __builtin_amdgcn_sched_barrier(0)
    Unit cur, nxt; int ui = 0;
    if (!S.next(0, cur)) return;
    f32x4 acc[2][2][4][2];
#pragma unroll
    for (int a = 0; a < 2; ++a)
#pragma unroll
        for (int b = 0; b < 2; ++b)
#pragma unroll
            for (int m = 0; m < 4; ++m)
#pragma unroll
                for (int n = 0; n < 2; ++n) acc[a][b][m][n] = (f32x4){0.f, 0.f, 0.f, 0.f};
    bf16x8 At[4][2], B0[2][2], B1[2][2];
    const char* cA = (const char*)g.A + (size_t)cur.pm * tstep + (size_t)cur.k0 * 2; const char* cB = (const char*)g.Bt + (size_t)cur.pn * tstep + (size_t)cur.k0 * 2;
    S.a_ready(cur);
    if constexpr (SP2) {
        PG8_STAGE(PG8_SB(0, 0), cB, voffB); PG8_STAGE(PG8_SB(0, 1), cB + hstep, voffB); PG8_STAGE(PG8_SA(0, 0), cA, voffA); PG8_STAGE(PG8_SA(0, 1), cA + hstep, voffA);
        if (wr == 1) PG8_BAR;
        PG8_WAIT_V(2); PG8_BAR;
        PG8_STAGE(PG8_SB(1, 0), cB + kstep, voffB); PG8_STAGE(PG8_SA(1, 0), cA + kstep, voffA); PG8_STAGE(PG8_SB(1, 1), cB + hstep + kstep, voffB);
        PG8_WAIT_V(6); PG8_BAR;
    } else {
        PG8_STAGE(PG8_SB(0, 0), cB, voffB); PG8_STAGE(PG8_SA(0, 0), cA, voffA); PG8_STAGE(PG8_SB(0, 1), cB + hstep, voffB); PG8_STAGE(PG8_SA(0, 1), cA + hstep, voffA);
        if (wr == 1) PG8_BAR;
        PG8_WAIT_V(4); PG8_BAR;
        PG8_STAGE(PG8_SB(1, 0), cB + kstep, voffB); PG8_STAGE(PG8_SA(1, 0), cA + kstep, voffA); PG8_STAGE(PG8_SB(1, 1), cB + hstep + kstep, voffB);
        PG8_WAIT_V(6); PG8_BAR;
    }
    for (;;) {
        const bool has_next = S.next(ui + 1, nxt);
        const char* nA = has_next ? (const char*)g.A + (size_t)nxt.pm * tstep + (size_t)nxt.k0 * 2 : cA; const char* nB = has_next ? (const char*)g.Bt + (size_t)nxt.pn * tstep + (size_t)nxt.k0 * 2 : cB;
        const int nt = cur.nt;
        for (int t = 0; t < nt; t += 2) {
            const bool last = (t == nt - 2);
            const char* a1 = cA + (size_t)(t + 1) * kstep;
            const char* a2 = last ? nA : cA + (size_t)(t + 2) * kstep; const char* b2 = last ? nB : cB + (size_t)(t + 2) * kstep;
            const char* a3 = a2 + kstep; const char* b3 = b2 + kstep;
            if (last && has_next) S.a_ready(nxt);
            if constexpr (SP2) {
            PG8_LDB(B0, 0, 0); PG8_LDB(B1, 0, 1); PG8_SCHED; PG8_LDA(At, 0, 0); PG8_STAGE(PG8_SA(1, 1), a1 + hstep, voffA);
            PG8_WAIT_V(8); PG8_WAIT_L(0); PG8_BAR; PG8_MMA(0, 0, At, B0); PG8_MMA(0, 1, At, B1); PG8_BAR; PG8_SCHED;
            PG8_LDA(At, 0, 1); PG8_STAGE(PG8_SB(0, 0), b2, voffB); PG8_STAGE(PG8_SB(0, 1), b2 + hstep, voffB); PG8_STAGE(PG8_SA(0, 0), a2, voffA);
            PG8_WAIT_V(8); PG8_WAIT_L(0); PG8_BAR; PG8_MMA(1, 0, At, B0); PG8_MMA(1, 1, At, B1); PG8_BAR; PG8_SCHED;
            PG8_LDB(B0, 1, 0); PG8_LDB(B1, 1, 1); PG8_SCHED; PG8_LDA(At, 1, 0); PG8_STAGE(PG8_SA(0, 1), a2 + hstep, voffA);
            PG8_WAIT_V(8); PG8_WAIT_L(0); PG8_BAR; PG8_MMA(0, 0, At, B0); PG8_MMA(0, 1, At, B1); PG8_BAR; PG8_SCHED;
            PG8_LDA(At, 1, 1); PG8_STAGE(PG8_SB(1, 0), b3, voffB); PG8_STAGE(PG8_SB(1, 1), b3 + hstep, voffB); PG8_STAGE(PG8_SA(1, 0), a3, voffA);
            PG8_WAIT_V(8); PG8_WAIT_L(0); PG8_BAR; PG8_MMA(1, 0, At, B0); PG8_MMA(1, 1, At, B1); PG8_BAR; PG8_SCHED;
            } else {
            PG8_LDB(B0, 0, 0); PG8_SCHED; PG8_LDA(At, 0, 0); PG8_STAGE(PG8_SA(1, 1), a1 + hstep, voffA);
            PG8_WAIT_L(8); PG8_BAR; PG8_WAIT_L(0); PG8_MMA(0, 0, At, B0); PG8_BAR; PG8_SCHED;
            PG8_LDB(B1, 0, 1); PG8_STAGE(PG8_SB(0, 0), b2, voffB);
            PG8_BAR; PG8_WAIT_L(0); PG8_MMA(0, 1, At, B1); PG8_BAR;
            PG8_LDA(At, 0, 1); PG8_STAGE(PG8_SA(0, 0), a2, voffA);
            PG8_BAR; PG8_WAIT_L(0); PG8_MMA(1, 0, At, B0); PG8_BAR; PG8_SCHED;
            PG8_STAGE(PG8_SB(0, 1), b2 + hstep, voffB);
            PG8_WAIT_V(6); PG8_BAR; PG8_MMA(1, 1, At, B1); PG8_BAR;
            PG8_LDB(B0, 1, 0); PG8_SCHED; PG8_LDA(At, 1, 0); PG8_STAGE(PG8_SA(0, 1), a2 + hstep, voffA);
            PG8_WAIT_L(8); PG8_BAR; PG8_WAIT_L(0); PG8_MMA(0, 0, At, B0); PG8_BAR; PG8_SCHED;
            PG8_LDB(B1, 1, 1); PG8_STAGE(PG8_SB(1, 0), b3, voffB);
            PG8_BAR; PG8_WAIT_L(0); PG8_MMA(0, 1, At, B1); PG8_BAR;
            PG8_LDA(At, 1, 1); PG8_STAGE(PG8_SA(1, 0), a3, voffA);
            PG8_BAR; PG8_WAIT_L(0); PG8_MMA(1, 0, At, B0); PG8_BAR; PG8_SCHED;
            PG8_STAGE(PG8_SB(1, 1), b3 + hstep, voffB);
            PG8_WAIT_V(6); PG8_BAR; PG8_MMA(1, 1, At, B1); PG8_BAR;
            }
        }
        if constexpr (ALIGN_EPI) { if (wr == 0) PG8_BAR; }
        if constexpr (!Epi::AFTER_DRAIN) { E(acc, cur, wr, wc, fr, fq); S.done(cur); }
        if (!has_next) break;
#pragma unroll
        for (int a = 0; a < 2; ++a)
#pragma unroll
            for (int b = 0; b < 2; ++b)
#pragma unroll
                for (int m = 0; m < 4; ++m)
#pragma unroll
                    for (int n = 0; n < 2; ++n) acc[a][b][m][n] = (f32x4){0.f, 0.f, 0.f, 0.f};
        cur = nxt; cA = nA; cB = nB; ++ui;
        if constexpr (ALIGN_EPI) { if (wr == 1) PG8_BAR; }
    }
    PG8_WAIT_V(0);
    if constexpr (!ALIGN_EPI) { if (wr == 0) PG8_BAR; }
    PG8_BAR;
    if constexpr (Epi::AFTER_DRAIN) { E.fused(acc, cur, wr, wc, fr, fq, lds, wid, lane); S.done(cur); }
#undef PG8_SA
#undef PG8_SB
#undef PG8_STAGE
#undef PG8_LDA
#undef PG8_LDB
#undef PG8_MMA
#undef PG8_WAIT_V
#undef PG8_WAIT_L
#undef PG8_BAR
#undef PG8_SCHED
}
}

#ifndef MK_ONE_LAUNCH
#define MK_ONE_LAUNCH 1
#endif
constexpr int NWAVES = 8;
constexpr int D = 4096, MC = 8192, MLAT = 4096, M = MC + MLAT, NPAN = M / 256;
constexpr int NPH = 14;
constexpr size_t MiB = 1u << 20;
constexpr size_t WS_CTL = 0, CTL_ZERO_BYTES = 64 * 1024;
constexpr size_t WS_MOD = 1 * MiB;
constexpr size_t WS_RSTD = 2 * MiB;
constexpr size_t WS_GB = 3 * MiB;
constexpr size_t WS_WUP = 10 * MiB;
constexpr size_t WS_WIN = 16 * MiB;
constexpr size_t WS_WOUT = 148 * MiB;
constexpr size_t WS_A = 180 * MiB;
constexpr size_t WS_B = 756 * MiB;
constexpr size_t WS_C = 1140 * MiB;
constexpr size_t WS_END = 1524 * MiB;
constexpr size_t O_Y = 0, O_RS = (size_t)M * D, O_GS = O_RS + (size_t)32 * 2 * 64 * 64 * 64, O_END = O_GS + (size_t)32 * 2 * 32 * 128 * 128;
constexpr size_t GS_G = 0;
constexpr size_t GS_MID = 96 * MiB;
constexpr size_t GS_AB = 108 * MiB;
constexpr int CW_BAR = 4096;

constexpr int RING_BYTES = 143360, LDSCTL_OFF = RING_BYTES, MISC_OFF = LDSCTL_OFF + 320, LDS_BYTES = 147456;

#define GAS __attribute__((address_space(1)))
#define LAS __attribute__((address_space(3)))
typedef unsigned short bf16;
typedef unsigned v4u __attribute__((ext_vector_type(4)));
typedef unsigned v2u __attribute__((ext_vector_type(2)));
typedef float f32x4 __attribute__((ext_vector_type(4)));
typedef GAS unsigned gu32;
#define RLX_AGENT __ATOMIC_RELAXED, __HIP_MEMORY_SCOPE_AGENT
#define LDS_WAIT() asm volatile("s_waitcnt lgkmcnt(0)" ::: "memory")
#define VM_WAIT() asm volatile("s_waitcnt vmcnt(0)" ::: "memory")
__device__ __forceinline__ unsigned f2bf(float f) { unsigned u = __builtin_bit_cast(unsigned, f); return (u + 0x7fffu + ((u >> 16) & 1u)) >> 16; }
typedef float f32x2_t __attribute__((ext_vector_type(2))); typedef __bf16 bf16x2_t __attribute__((ext_vector_type(2)));
__device__ __forceinline__ unsigned cvtpk(float lo, float hi) { f32x2_t v = {lo, hi}; bf16x2_t b = __builtin_convertvector(v, bf16x2_t); return __builtin_bit_cast(unsigned, b); }
__device__ __forceinline__ unsigned pk2(float lo, float hi) { return cvtpk(lo, hi); }
__device__ __forceinline__ float bf2f(unsigned short b) { return __builtin_bit_cast(float, (unsigned)b << 16); }
__device__ __forceinline__ f32x4 bf4(v2u w) { f32x4 r; r.x = __builtin_bit_cast(float, w.x << 16); r.y = __builtin_bit_cast(float, w.x & 0xffff0000u); r.z = __builtin_bit_cast(float, w.y << 16); r.w = __builtin_bit_cast(float, w.y & 0xffff0000u); return r; }
__device__ __forceinline__ v2u pk4(f32x4 v) { v2u r; r.x = pk2(v.x, v.y); r.y = pk2(v.z, v.w); return r; }
__device__ __forceinline__ float sigmoidf_(float x) { return __builtin_amdgcn_rcpf(1.f + __expf(-x)); }
__device__ __forceinline__ float siluf_(float x) { return x * __builtin_amdgcn_rcpf(1.f + __expf(-x)); }
__device__ __forceinline__ float softplusf_(float x) { return fmaxf(x, 0.f) + log1pf(__expf(-fabsf(x))); }
__device__ __forceinline__ f32x4 silu4(f32x4 v) { f32x4 r; r.x = siluf_(v.x); r.y = siluf_(v.y); r.z = siluf_(v.z); r.w = siluf_(v.w); return r; }
#define XB_TMO      128
#define XB_XCNT(j)  (256  + 64 * (j))
#define XB_XSUB(j)  (1280 + 64 * (j))
#define XB_XGEN(j)  (2304 + 64 * (j))
#define XB_TOP      3328
#define XB_TOPGEN   3392
#define XCD_BAR_WORDS 3456
#define XB_SPIN_CAP (1u << 18)

__device__ __forceinline__ unsigned xb_ld(unsigned* p)              { return __hip_atomic_load(p, __ATOMIC_RELAXED, __HIP_MEMORY_SCOPE_AGENT); }
__device__ __forceinline__ unsigned xb_add(unsigned* p, unsigned v) { return __hip_atomic_fetch_add(p, v, __ATOMIC_RELAXED, __HIP_MEMORY_SCOPE_AGENT); }
__device__ __forceinline__ unsigned xb_xcc_id() { return (unsigned)__builtin_amdgcn_s_getreg((3 << 11) | 20) & 0xFu; }
#define XB_SPIN(cond, bar) do { unsigned _sp = 0; while (cond) { __builtin_amdgcn_s_sleep(1); \
    if ((++_sp & 255u) == 0u) { if (xb_ld(&(bar)[XB_TMO])) break; if (_sp > XB_SPIN_CAP) { atomicAdd(&(bar)[XB_TMO], 1u); break; } } } } while (0)

struct XcdBarrier {
    unsigned* bar; unsigned x;
    volatile LAS unsigned* st;
};

__device__ __forceinline__ XcdBarrier xcd_barrier_post(unsigned* bar, volatile LAS unsigned* st) {
    XcdBarrier b; b.bar = bar; b.x = xb_xcc_id(); b.st = st;
    if (threadIdx.x == 0) (void)xb_add(&bar[XB_XCNT(b.x)], 1u);
    return b;
}
__device__ __forceinline__ void xcd_barrier_complete(unsigned* bar, unsigned x, unsigned& nloc, unsigned& nx) {
    const unsigned G = gridDim.x * gridDim.y * gridDim.z;
    unsigned sum, cnt, mine, sp = 0u;
    for (;;) {
        sum = 0u; cnt = 0u; mine = 0u;
#pragma unroll
        for (unsigned j = 0; j < 16; ++j) { const unsigned c = xb_ld(&bar[XB_XCNT(j)]); sum += c; cnt += (c > 0u) ? 1u : 0u; mine = (j == x) ? c : mine; }
        if (sum == G) break;
        __builtin_amdgcn_s_sleep(1);
        if ((++sp & 255u) == 0u) { if (xb_ld(&bar[XB_TMO])) break; if (sp > XB_SPIN_CAP) { atomicAdd(&bar[XB_TMO], 1u); break; } }
    }
    nloc = mine > 0u ? mine : 1u; nx = cnt > 0u ? cnt : 1u;
}

__device__ __forceinline__ void xcd_barrier(const XcdBarrier& b) {
    asm volatile("s_waitcnt vmcnt(0)" ::: "memory");
    __syncthreads();
    if (threadIdx.x == 0) {
        unsigned* bar = b.bar;
        __builtin_amdgcn_s_waitcnt(0);
        unsigned nloc = b.st[0], nx = b.st[1];
        if (nloc == 0u) { xcd_barrier_complete(bar, b.x, nloc, nx); b.st[0] = nloc; b.st[1] = nx; }
        const unsigned old = xb_add(&bar[XB_XSUB(b.x)], 1u);
        const unsigned gen = old / nloc;
        if (old + 1u == (gen + 1u) * nloc) {
            __builtin_amdgcn_fence(__ATOMIC_RELEASE, "agent");
            asm volatile("s_waitcnt vmcnt(0)" ::: "memory");
            const unsigned og = xb_add(&bar[XB_TOP], 1u);
            const unsigned tg = og / nx;
            if (og + 1u == (tg + 1u) * nx) xb_add(&bar[XB_TOPGEN], 1u);
            else XB_SPIN(xb_ld(&bar[XB_TOPGEN]) == tg, bar);
            __builtin_amdgcn_fence(__ATOMIC_ACQUIRE, "agent");
            xb_add(&bar[XB_XGEN(b.x)], 1u);
            asm volatile("s_waitcnt vmcnt(0)" ::: "memory");
        } else {
            XB_SPIN(xb_ld(&bar[XB_XGEN(b.x)]) == gen, bar);
            __builtin_amdgcn_fence(__ATOMIC_ACQUIRE, "agent");
            asm volatile("s_waitcnt vmcnt(0)" ::: "memory");
        }
    }
    __syncthreads();
}
__device__ __forceinline__ float wave_sum(float v) {
#pragma unroll
    for (int o = 1; o < 64; o <<= 1) v += __shfl_xor(v, o);
    return v;
}
__device__ __forceinline__ void p0_transpose_item(const float* W, int K, int N, bf16* WT, int row_off, LAS float* scr, int item, int lane) {
    const int nblk = N / 32, kb = item / nblk, nb = item % nblk, k0 = 64 * kb, n0 = 32 * nb;
#pragma unroll
    for (int i = 0; i < 8; ++i) { const int kk = 8 * i + (lane >> 3); const f32x4 w = __builtin_nontemporal_load((const f32x4*)(W + (size_t)(k0 + kk) * N + n0 + 4 * (lane & 7)));
        LAS float* d = scr + kk * 33 + 4 * (lane & 7); d[0] = w.x; d[1] = w.y; d[2] = w.z; d[3] = w.w; }
    LDS_WAIT(); asm volatile("" ::: "memory");
    const int c = lane & 7;
#pragma unroll
    for (int j = 0; j < 4; ++j) { const int n = (lane >> 3) + 8 * j; const LAS float* s = scr + (8 * c) * 33 + n;
        v4u o; o.x = pk2(s[0 * 33], s[1 * 33]); o.y = pk2(s[2 * 33], s[3 * 33]); o.z = pk2(s[4 * 33], s[5 * 33]); o.w = pk2(s[6 * 33], s[7 * 33]);
        *(GAS v4u*)(WT + (size_t)(row_off + n0 + n) * K + k0 + 8 * c) = o; }
    LDS_WAIT(); asm volatile("" ::: "memory");
}

typedef short bf16x8 __attribute__((ext_vector_type(8)));
typedef float f32x16 __attribute__((ext_vector_type(16)));
typedef short s16x4 __attribute__((ext_vector_type(4)));
typedef short v4i16_t __attribute__((ext_vector_type(4)));
#define MFMA32(a, b, c) __builtin_amdgcn_mfma_f32_32x32x16_bf16((a), (b), (c), 0, 0, 0)
#define WG_BAR() do { asm volatile("s_waitcnt vmcnt(0) lgkmcnt(0)" ::: "memory"); __builtin_amdgcn_s_barrier(); asm volatile("" ::: "memory"); } while (0)
#define LDS_BAR() do { asm volatile("s_waitcnt lgkmcnt(0)" ::: "memory"); __builtin_amdgcn_s_barrier(); asm volatile("" ::: "memory"); } while (0)

__device__ __forceinline__ bf16x8 frag_row(LAS unsigned char* img, int P, int row0, int s, int lane) {
    return *(const LAS bf16x8*)(img + (row0 + (lane & 31)) * P + (16 * s + 8 * (lane >> 5)) * 2);
}
__device__ __forceinline__ bf16x8 frag_tr(LAS unsigned char* img, int P, int k0, int n0, int lane) {
    const int h = lane >> 5, blk = (lane >> 4) & 1, q = (lane & 15) >> 2, p = lane & 3;
    LAS unsigned char* a = img + (k0 + 8 * h + q) * P + n0 * 2 + 32 * blk + 8 * p;
    const s16x4 lo = __builtin_bit_cast(s16x4, __builtin_amdgcn_ds_read_tr16_b64_v4i16((LAS v4i16_t*)a));
    const s16x4 hi = __builtin_bit_cast(s16x4, __builtin_amdgcn_ds_read_tr16_b64_v4i16((LAS v4i16_t*)(a + 4 * P)));
    return __builtin_shufflevector(lo, hi, 0, 1, 2, 3, 4, 5, 6, 7);
}
__device__ __forceinline__ float wave_sum_dpp(float v) {
#define DPP_(x, ctrl, rmask) __builtin_bit_cast(float, __builtin_amdgcn_update_dpp(0, __builtin_bit_cast(int, (x)), (ctrl), (rmask), 0xf, false))
    v += DPP_(v, 0xB1, 0xf);
    v += DPP_(v, 0x4E, 0xf);
    v += DPP_(v, 0x141, 0xf);
    v += DPP_(v, 0x140, 0xf);
    v += DPP_(v, 0x142, 0xa);
    v += DPP_(v, 0x143, 0xc);
#undef DPP_
    return __builtin_bit_cast(float, __builtin_amdgcn_readlane(__builtin_bit_cast(int, v), 63));
}
__device__ __forceinline__ float wave_incl_scan_dpp(float v) {
#define DPP_(x, ctrl, rmask) __builtin_bit_cast(float, __builtin_amdgcn_update_dpp(0, __builtin_bit_cast(int, (x)), (ctrl), (rmask), 0xf, false))
    v += DPP_(v, 0x111, 0xf); v += DPP_(v, 0x112, 0xf); v += DPP_(v, 0x114, 0xf); v += DPP_(v, 0x118, 0xf);
    v += DPP_(v, 0x142, 0xa); v += DPP_(v, 0x143, 0xc);
#undef DPP_
    return v;
}
__device__ __forceinline__ int crow(int i, int h) { return (i & 3) + 8 * (i >> 2) + 4 * h; }
__device__ __forceinline__ void store_tile_T(LAS unsigned char* img, int P, int n0, int m0, const f32x16& acc, int lane) {
    LAS unsigned char* p = img + (n0 + (lane & 31)) * P + (m0 + 4 * (lane >> 5)) * 2;
#pragma unroll
    for (int g = 0; g < 4; ++g) { v2u w; w.x = cvtpk(acc[4 * g], acc[4 * g + 1]); w.y = cvtpk(acc[4 * g + 2], acc[4 * g + 3]); *(LAS v2u*)(p + 16 * g) = w; }
}
__device__ __forceinline__ f32x16 zero16() { f32x16 z; for (int i = 0; i < 16; ++i) z[i] = 0.f; return z; }


__device__ __forceinline__ f32x16 ltri_tile(LAS unsigned char* X, LAS unsigned char* Y, int t, int lane) {
    f32x16 acc = zero16();
    const int mb = t ? 32 : 0, nb = (t == 2) ? 32 : 0;
#pragma unroll
    for (int ks = 0; ks < 4; ++ks) { if ((t == 0 && ks >= 2) || (t == 2 && ks < 2)) continue; acc = MFMA32(frag_tr(Y, 144, 16 * ks, nb, lane), frag_row(X, 144, mb, ks, lane), acc); }
    return acc;
}
__device__ __forceinline__ void ltri_store1(LAS unsigned char* img, int t, const f32x16& acc, int lane) { store_tile_T(img, 144, t ? 32 : 0, (t == 2) ? 32 : 0, acc, lane); }
__device__ __forceinline__ void tri_inverse64(LAS unsigned char* LF, LAS unsigned char* LOFF, LAS unsigned char* DD, LAS unsigned char* NI, LAS unsigned char* N2I, LAS unsigned char* SI, int lane) {
    const int b = lane >> 4; const int hh = lane >> 5, l31 = lane & 31;
    {
        unsigned lfa = (unsigned)(size_t)LF + (unsigned)b * (16u * 272u + 64u); asm volatile("" : "+v"(lfa));
        LAS unsigned char* lf = (LAS unsigned char*)(size_t)lfa;
        int c_o = lane & 15; asm volatile("" : "+v"(c_o));
        float Td[16];
#pragma unroll
        for (int i = 0; i < 16; ++i) {
            float a0 = (c_o == i) ? 1.f : 0.f, a1 = 0.f, a2 = 0.f, a3 = 0.f;
#pragma unroll
            for (int j4 = 0; j4 < (i + 3) / 4; ++j4) { const f32x4 l = *(const LAS f32x4*)(lf + i * 272 + j4 * 16);
                if (4 * j4 + 0 < i) a0 -= l.x * Td[4 * j4 + 0]; if (4 * j4 + 1 < i) a1 -= l.y * Td[4 * j4 + 1]; if (4 * j4 + 2 < i) a2 -= l.z * Td[4 * j4 + 2]; if (4 * j4 + 3 < i) a3 -= l.w * Td[4 * j4 + 3]; }
            Td[i] = (a0 + a1) + (a2 + a3);
        }
        asm volatile("" ::: "memory");
        LAS unsigned char* dd = DD + lane * 2;
#pragma unroll
        for (int bb = 0; bb < 4; ++bb)
#pragma unroll
            for (int ii = 0; ii < 16; ++ii) *(LAS bf16*)(dd + (16 * bb + ii) * 144) = (bf16)f2bf(bb == b ? Td[ii] : 0.f);
    }
    asm volatile("" ::: "memory");
    f32x16 sacc[3];
    {
        f32x16 p[3];
#pragma unroll
        for (int t = 0; t < 3; ++t) p[t] = ltri_tile(DD, LOFF, t, lane);
#pragma unroll
        for (int t = 0; t < 3; ++t) { ltri_store1(NI, t, p[t], lane);
#pragma unroll
            for (int r = 0; r < 16; ++r) sacc[t][r] = ((t != 1 && l31 == crow(r, hh)) ? 1.f : 0.f) - p[t][r]; }
    }
    asm volatile("" ::: "memory");
    {
        f32x16 p[3];
#pragma unroll
        for (int t = 0; t < 3; ++t) p[t] = ltri_tile(NI, NI, t, lane);
#pragma unroll
        for (int t = 0; t < 3; ++t) { ltri_store1(N2I, t, p[t], lane);
#pragma unroll
            for (int r = 0; r < 16; ++r) sacc[t][r] += p[t][r]; }
    }
    asm volatile("" ::: "memory");
    {
        f32x16 p[3];
#pragma unroll
        for (int t = 0; t < 3; ++t) p[t] = ltri_tile(NI, N2I, t, lane);
#pragma unroll
        for (int t = 0; t < 3; ++t)
#pragma unroll
            for (int r = 0; r < 16; ++r) sacc[t][r] -= p[t][r];
    }
    asm volatile("" ::: "memory");
#pragma unroll
    for (int t = 0; t < 3; ++t) ltri_store1(SI, t, sacc[t], lane);
    asm volatile("" ::: "memory");
}


__device__ __forceinline__ void inv_stepA(LAS unsigned char* LF, LAS unsigned char* DD, int lane) {
    const int b = lane >> 4;
    unsigned lfa = (unsigned)(size_t)LF + (unsigned)b * (16u * 272u + 64u); asm volatile("" : "+v"(lfa));
    LAS unsigned char* lf = (LAS unsigned char*)(size_t)lfa;
    int c_o = lane & 15; asm volatile("" : "+v"(c_o));
    float Td[16];
#pragma unroll
    for (int i = 0; i < 16; ++i) {
        float a0 = (c_o == i) ? 1.f : 0.f, a1 = 0.f, a2 = 0.f, a3 = 0.f;
#pragma unroll
        for (int j4 = 0; j4 < (i + 3) / 4; ++j4) { const f32x4 l = *(const LAS f32x4*)(lf + i * 272 + j4 * 16);
            if (4 * j4 + 0 < i) a0 -= l.x * Td[4 * j4 + 0]; if (4 * j4 + 1 < i) a1 -= l.y * Td[4 * j4 + 1]; if (4 * j4 + 2 < i) a2 -= l.z * Td[4 * j4 + 2]; if (4 * j4 + 3 < i) a3 -= l.w * Td[4 * j4 + 3]; }
        Td[i] = (a0 + a1) + (a2 + a3);
    }
    asm volatile("" ::: "memory");
    LAS unsigned char* dd = DD + lane * 2 + b * (16 * 144);
#pragma unroll
    for (int ii = 0; ii < 16; ++ii) *(LAS bf16*)(dd + ii * 144) = (bf16)(cvtpk(Td[ii], 0.f) & 0xffffu);
}
__device__ __forceinline__ void inv_zero_offdiag(LAS unsigned char* DD, int w, int lane) {
    const int bi = lane >> 4, bj = (bi + w) & 3; LAS unsigned char* p = DD + lane * 144 + bj * 32;
    *(LAS v4u*)p = (v4u){0u, 0u, 0u, 0u}; *(LAS v4u*)(p + 16) = (v4u){0u, 0u, 0u, 0u};
}
__device__ __forceinline__ f32x16 ltri_tile_rt(LAS unsigned char* X, LAS unsigned char* Y, int t, int lane) {
    f32x16 acc = zero16();
    const int mb = t ? 32 : 0, nb = (t == 2) ? 32 : 0;
    if (t != 2) {
#pragma unroll
        for (int ks = 0; ks < 2; ++ks) acc = MFMA32(frag_tr(Y, 144, 16 * ks, nb, lane), frag_row(X, 144, mb, ks, lane), acc);
    }
    if (t != 0) {
#pragma unroll
        for (int ks = 2; ks < 4; ++ks) acc = MFMA32(frag_tr(Y, 144, 16 * ks, nb, lane), frag_row(X, 144, mb, ks, lane), acc);
    }
    return acc;
}

namespace rk {
constexpr int P = 144, IMG = 64 * P;
constexpr int O_KKD = 0, O_RD = IMG, O_BI = 2 * IMG, O_KI = 3 * IMG, O_KET = 4 * IMG, O_BET = 5 * IMG, O_VT = 6 * IMG  , O_AKK = 7 * IMG, O_UT = 7 * IMG  ,
              O_ARB = 8 * IMG, O_ARK = 9 * IMG, O_T = 10 * IMG, O_XT = 11 * IMG, O_HT = 12 * IMG, O_LF = 13 * IMG, PLF = 272, O_GAM = O_LF + 64 * PLF, O_WTOT = O_GAM + 256, O_END = O_WTOT + 2048;
static_assert(O_END <= 143360, "rwkv chunk LDS map");
}
struct RkStep { int row0, T, h, d, n, nch; const float* sinit; float* sfin; };
__device__ __forceinline__ bool rk_unit(int u, RkStep& s, const float* state_rwkv, float* RS) {
    if (u >= 4608) return false;
    if (u < 512) { const int bl = u >> 7, rem = u & 127; s.h = rem >> 1; s.d = rem & 1; s.row0 = MC + bl * 1024; s.T = 1024; s.nch = 16; s.sinit = state_rwkv + ((size_t)(bl * 2 + s.d) * 64 + s.h) * 4096; s.sfin = nullptr; }
    else { const int ct = u - 512, b = ct >> 7, rem = ct & 127; s.h = rem >> 1; s.d = rem & 1; s.row0 = b * 256; s.T = 256; s.nch = 4; s.sinit = nullptr; s.sfin = RS + ((size_t)(b * 2 + s.d) * 64 + s.h) * 4096; }
    s.n = 0; return true;
}
__device__ __forceinline__ int rk_row(const RkStep& s, int tau) { const int tt = s.n * 64 + tau; return s.row0 + (s.d ? (s.T - 1 - tt) : tt); }

__device__ __forceinline__ void rwkv_chunk_phase(LAS unsigned char* lds, int tid, int lane, int wave, int bx, int G, const bf16* RKVZ, const bf16* LWIC, const float* k_k, const float* k_a,
                                                 const float* state_rwkv, float* RS, bf16* YF, bf16* YB,
                                                 const float* gw_in, const float* gw_ab, const float* gw_out, bf16* WIN1, bf16* GOUT1) {
    using namespace rk;
    RkStep st;
    int u = bx;
    bool have = rk_unit(u, st, state_rwkv, RS);
    v4u qr, qk, qv, qw, qi; qr = qk = qv = qw = qi = (v4u){0u, 0u, 0u, 0u};
    if (have) { const size_t o = (size_t)rk_row(st, 8 * wave + (lane >> 3)) * D + st.h * 64 + (lane & 7) * 8;
        qr = *(const v4u*)(RKVZ + o); qk = *(const v4u*)(RKVZ + (size_t)M * D + o); qv = *(const v4u*)(RKVZ + (size_t)2 * M * D + o); qw = *(const v4u*)(LWIC + (size_t)st.d * M * D + o); qi = *(const v4u*)(LWIC + (size_t)(2 + st.d) * M * D + o); }
    f32x16 hacc = zero16();
    const int tb = (wave & 3) >> 1, vb = wave & 1;
    const int lane_in = lane; float kkc = 0.f, kac = 0.f;
    float tv[32]; bf16* tdst = nullptr; bool tpend = false; int tslot = 0;
#define TR_ITEMS 161
#define TR_FINISH() do { if (tpend) { _Pragma("unroll") for (int k_ = 0; k_ < 32; ++k_) asm volatile("" : "+v"(tv[k_])); \
        _Pragma("unroll") for (int q_ = 0; q_ < 4; ++q_) { v4u w_; w_.x = cvtpk(tv[8 * q_], tv[8 * q_ + 1]); w_.y = cvtpk(tv[8 * q_ + 2], tv[8 * q_ + 3]); w_.z = cvtpk(tv[8 * q_ + 4], tv[8 * q_ + 5]); w_.w = cvtpk(tv[8 * q_ + 6], tv[8 * q_ + 7]); *(v4u*)(tdst + 8 * q_) = w_; } \
        tpend = false; } } while (0)
#define TR_START() do { const int slot_ = tslot * 2 + (wave >> 2); ++tslot; if (slot_ < TR_ITEMS) { const int item_ = bx * TR_ITEMS + slot_, nb_ = item_ >> 7, k0_ = (item_ & 127) * 32; const float* src_; int ns_; \
        if (nb_ < 256) { src_ = gw_in + (size_t)k0_ * 16384 + nb_ * 64 + lane_in; ns_ = 16384; tdst = WIN1 + (size_t)(nb_ * 64 + lane_in) * 4096 + k0_; } \
        else if (nb_ < 258) { src_ = gw_ab + (size_t)k0_ * 128 + (nb_ - 256) * 64 + lane_in; ns_ = 128; tdst = WIN1 + (size_t)(16384 + (nb_ - 256) * 64 + lane_in) * 4096 + k0_; } \
        else { src_ = gw_out + (size_t)k0_ * 4096 + (nb_ - 258) * 64 + lane_in; ns_ = 4096; tdst = GOUT1 + (size_t)((nb_ - 258) * 64 + lane_in) * 4096 + k0_; } \
        _Pragma("unroll") for (int k_ = 0; k_ < 32; ++k_) tv[k_] = __builtin_nontemporal_load(src_ + (size_t)k_ * ns_); tpend = true; } } while (0)
    while (have) {
        int lane = lane_in; asm volatile("" : "+v"(lane));
        const int hh = lane >> 5, l31 = lane & 31;
        if (st.n == 0) { const int c = st.h * 64 + lane; kkc = k_k[c]; kac = k_a[c]; }
        if (st.n == 0 && wave >= 4) {
            if (st.sinit) {
#pragma unroll
                for (int g = 0; g < 4; ++g) { const f32x4 v = *(const f32x4*)(st.sinit + (size_t)(vb * 32 + l31) * 64 + tb * 32 + 8 * g + 4 * hh); hacc[4 * g] = v.x; hacc[4 * g + 1] = v.y; hacc[4 * g + 2] = v.z; hacc[4 * g + 3] = v.w; }
            } else hacc = zero16();
            store_tile_T(lds + O_HT, P, vb * 32, tb * 32, hacc, lane);
        }
        float fr[8], fk[8], fw[8], fi[8];
        {
            asm volatile("" : "+v"(qr), "+v"(qk), "+v"(qv), "+v"(qw), "+v"(qi));
            const int ro = (8 * wave + (lane >> 3)) * P + (lane & 7) * 16;
            *(LAS v4u*)(lds + O_RD + ro) = qr; *(LAS v4u*)(lds + O_KKD + ro) = qk; *(LAS v4u*)(lds + O_BI + ro) = qw; *(LAS v4u*)(lds + O_KI + ro) = qi; *(LAS v4u*)(lds + O_VT + ro) = qv;
#pragma unroll
            for (int i = 0; i < 8; ++i) { const int a = (8 * wave + i) * P + lane * 2;
                fr[i] = bf2f(*(const LAS bf16*)(lds + O_RD + a)); fk[i] = bf2f(*(const LAS bf16*)(lds + O_KKD + a)); fw[i] = bf2f(*(const LAS bf16*)(lds + O_BI + a)); fi[i] = bf2f(*(const LAS bf16*)(lds + O_KI + a)); }
            asm volatile("" ::: "memory");
        }
        float gl[8]; { float run = 0.f;
#pragma unroll
            for (int i = 0; i < 8; ++i) { run += fw[i]; gl[i] = run; } }
        ((LAS float*)(lds + O_WTOT))[wave * 64 + lane] = gl[7];
        LDS_BAR();
        float prefix = 0.f, gtot = 0.f;
#pragma unroll
        for (int w2 = 0; w2 < 8; ++w2) { const float t = ((LAS float*)(lds + O_WTOT))[w2 * 64 + lane]; if (w2 < wave) prefix += t; gtot += t; }
        {
            float ket[8], bet[8];
            float eprev = __expf(prefix);
            const float egt = __expf(gtot); if (wave == 0) ((LAS float*)(lds + O_GAM))[lane] = egt;
#pragma unroll
            for (int i = 0; i < 8; ++i) {
                const float Gi = prefix + gl[i];
                const float kkv = fk[i] * kkc; const float nrm = wave_sum_dpp(kkv * kkv); const float kk = kkv * rsqrtf(nrm + 1e-6f);
                const float bb = kk * fi[i], kt = fk[i] * (1.f + (fi[i] - 1.f) * kac);
                const float eG = __expf(Gi), enG = __builtin_amdgcn_rcpf(eG), eC = egt * enG;
                const int tau = 8 * wave + i;
                *(LAS bf16*)(lds + O_KKD + tau * P + lane * 2) = (bf16)cvtpk(kk * eprev, 0.f);
                *(LAS bf16*)(lds + O_RD + tau * P + lane * 2) = (bf16)cvtpk(fr[i] * eG, 0.f);
                *(LAS bf16*)(lds + O_BI + tau * P + lane * 2) = (bf16)cvtpk(bb * enG, 0.f);
                *(LAS bf16*)(lds + O_KI + tau * P + lane * 2) = (bf16)cvtpk(kt * enG, 0.f);
                ket[i] = kt * eC; bet[i] = -bb * eC; eprev = eG;
            }
            v4u w;
            w.x = cvtpk(ket[0], ket[1]); w.y = cvtpk(ket[2], ket[3]); w.z = cvtpk(ket[4], ket[5]); w.w = cvtpk(ket[6], ket[7]); *(LAS v4u*)(lds + O_KET + lane * P + 16 * wave) = w;
            w.x = cvtpk(bet[0], bet[1]); w.y = cvtpk(bet[2], bet[3]); w.z = cvtpk(bet[4], bet[5]); w.w = cvtpk(bet[6], bet[7]); *(LAS v4u*)(lds + O_BET + lane * P + 16 * wave) = w;
        }
        LDS_BAR();
        RkStep nx = st; bool nhave = true; int nu = u;
        if (st.n + 1 < st.nch) nx.n = st.n + 1; else { nu = u + G; nhave = rk_unit(nu, nx, state_rwkv, RS); }
        if (nhave) { const size_t o = (size_t)rk_row(nx, 8 * wave + (lane >> 3)) * D + nx.h * 64 + (lane & 7) * 8;
            qr = *(const v4u*)(RKVZ + o); qk = *(const v4u*)(RKVZ + (size_t)M * D + o); qv = *(const v4u*)(RKVZ + (size_t)2 * M * D + o); qw = *(const v4u*)(LWIC + (size_t)nx.d * M * D + o); qi = *(const v4u*)(LWIC + (size_t)(2 + nx.d) * M * D + o); }
#define RK_TILE(mat_, kind_) do { const int mat = (mat_), sb = ((kind_) == 1) ? 1 : 0, tbb = ((kind_) == 0) ? 0 : 1; \
            LAS unsigned char* srcS = lds + ((mat & 1) ? O_KI : O_BI); LAS unsigned char* srcT = lds + ((mat & 2) ? O_RD : O_KKD); \
            f32x16 acc = zero16(); \
            _Pragma("unroll") for (int ks = 0; ks < 4; ++ks) acc = MFMA32(frag_row(srcS, P, sb * 32, ks, lane), frag_row(srcT, P, tbb * 32, ks, lane), acc); \
            const int t = tbb * 32 + l31; \
            LAS unsigned char* dst = lds + (mat == 0 ? O_T   : (mat == 1 ? O_AKK : (mat == 2 ? O_ARB : O_ARK))); \
            if (sb == tbb) {                                                \
                const int dlt = l31 - 4 * hh; \
                _Pragma("unroll") for (int i = 0; i < 16; ++i) { const int ci = (i & 3) + 8 * (i >> 2); const bool keep = (mat < 2) ? (ci < dlt) : (ci <= dlt); acc[i] = keep ? (mat == 2 ? -acc[i] : acc[i]) : 0.f; } \
                if (mat == 0) {                                             \
                    _Pragma("unroll") for (int g = 0; g < 4; ++g) *(LAS f32x4*)(lds + O_LF + t * PLF + (sb * 32 + 8 * g + 4 * hh) * 4) = (f32x4){acc[4 * g], acc[4 * g + 1], acc[4 * g + 2], acc[4 * g + 3]}; \
                    _Pragma("unroll") for (int i = 0; i < 16; ++i) { const int ci = (i & 3) + 8 * (i >> 2) + 4 * hh; if ((ci >> 4) == (l31 >> 4)) acc[i] = 0.f; } \
                } \
            } else if (mat == 2) { _Pragma("unroll") for (int i = 0; i < 16; ++i) acc[i] = -acc[i]; } \
            store_tile_T(dst, P, tbb * 32, sb * 32, acc, lane); } while (0)
        RK_TILE((wave < 3) ? 0 : (wave < 6 ? 2 : 1), (wave < 6) ? (wave % 3) : (wave - 6));
        LDS_BAR();
        f32x16 yacc = zero16(), isacc = zero16();
        if (wave == 3) inv_stepA(lds + O_LF, lds + O_BI, lane);
        asm volatile("" ::: "memory");
#define RK_XTILE() do { \
            f32x16 acc = zero16(); \
_Pragma("unroll") \
            for (int ks = 0; ks < 4; ++ks) { if (ks < 2 * (tb + 1)) acc = MFMA32(frag_row(lds + O_AKK, P, tb * 32, ks, lane), frag_tr(lds + O_VT, P, 16 * ks, vb * 32, lane), acc); } \
_Pragma("unroll") \
            for (int ks = 0; ks < 4; ++ks) acc = MFMA32(frag_row(lds + O_KKD, P, tb * 32, ks, lane), frag_row(lds + O_HT, P, vb * 32, ks, lane), acc); \
            store_tile_T(lds + O_XT, P, vb * 32, tb * 32, acc, lane); } while (0)
        if (wave >= 4) RK_TILE((wave == 4) ? 1 : 3, (wave == 4) ? 2 : (wave - 5));
#define RK_YPART() do { \
            _Pragma("unroll") for (int ks = 0; ks < 4; ++ks) yacc = MFMA32(frag_row(lds + O_HT, P, vb * 32, ks, lane), frag_row(lds + O_RD, P, tb * 32, ks, lane), yacc); } while (0)
        if (wave < 3) { inv_zero_offdiag(lds + O_BI, wave + 1, lane); RK_YPART(); }
        LDS_BAR();
        if (wave == 3) RK_YPART();
        if (wave >= 4) RK_XTILE();
        if ((wave & 3) == 3) { TR_FINISH(); TR_START(); }
        if (wave < 3) { const f32x16 p_ = ltri_tile_rt(lds + O_BI, lds + O_T, wave, lane); ltri_store1(lds + O_KI, wave, p_, lane);
#pragma unroll
            for (int r = 0; r < 16; ++r) isacc[r] = ((wave != 1 && l31 == crow(r, hh)) ? 1.f : 0.f) - p_[r]; }
        LDS_BAR();
        if (wave < 3) { const f32x16 p_ = ltri_tile_rt(lds + O_KI, lds + O_KI, wave, lane); ltri_store1(lds + O_LF, wave, p_, lane);
#pragma unroll
            for (int r = 0; r < 16; ++r) isacc[r] += p_[r]; }
        LDS_BAR();
        if (wave < 3) { const f32x16 p_ = ltri_tile_rt(lds + O_KI, lds + O_LF, wave, lane);
#pragma unroll
            for (int r = 0; r < 16; ++r) isacc[r] -= p_[r];
            ltri_store1(lds + O_T, wave, isacc, lane); }
        LDS_BAR();
        if (wave < 3) { const f32x16 p_ = ltri_tile_rt(lds + O_T, lds + O_BI, wave, lane); ltri_store1(lds + O_KI, wave, p_, lane); }
#undef RK_YPART
#undef RK_XTILE
#undef RK_TILE
        LDS_BAR();
        if (wave >= 4) {
            f32x16 acc = zero16();
#pragma unroll
            for (int ks = 0; ks < 4; ++ks) { if (ks < 2 * (tb + 1)) acc = MFMA32(frag_row(lds + O_KI, P, tb * 32, ks, lane), frag_row(lds + O_XT, P, vb * 32, ks, lane), acc); }
            store_tile_T(lds + O_UT, P, vb * 32, tb * 32, acc, lane);
        }
        LDS_BAR();
        if (wave < 4) {
#pragma unroll
            for (int ks = 0; ks < 4; ++ks) { if (ks < 2 * (tb + 1)) { yacc = MFMA32(frag_tr(lds + O_VT, P, 16 * ks, vb * 32, lane), frag_row(lds + O_ARK, P, tb * 32, ks, lane), yacc);
                                                                      yacc = MFMA32(frag_row(lds + O_UT, P, vb * 32, ks, lane), frag_row(lds + O_ARB, P, tb * 32, ks, lane), yacc); } }
            bf16* Yd = (st.d ? YB : YF) + (size_t)rk_row(st, tb * 32 + l31) * D + st.h * 64 + vb * 32 + 4 * hh;
#pragma unroll
            for (int g = 0; g < 4; ++g) { v2u w; w.x = cvtpk(yacc[4 * g], yacc[4 * g + 1]); w.y = cvtpk(yacc[4 * g + 2], yacc[4 * g + 3]); *(v2u*)(Yd + 8 * g) = w; }
        } else {
#pragma unroll
            for (int g = 0; g < 4; ++g) { const f32x4 gm = *(const LAS f32x4*)(lds + O_GAM + (tb * 32 + 8 * g + 4 * hh) * 4); hacc[4 * g] *= gm.x; hacc[4 * g + 1] *= gm.y; hacc[4 * g + 2] *= gm.z; hacc[4 * g + 3] *= gm.w; }
#pragma unroll
            for (int ks = 0; ks < 4; ++ks) hacc = MFMA32(frag_row(lds + O_KET, P, tb * 32, ks, lane), frag_tr(lds + O_VT, P, 16 * ks, vb * 32, lane), hacc);
#pragma unroll
            for (int ks = 0; ks < 4; ++ks) hacc = MFMA32(frag_row(lds + O_BET, P, tb * 32, ks, lane), frag_row(lds + O_UT, P, vb * 32, ks, lane), hacc);
            store_tile_T(lds + O_HT, P, vb * 32, tb * 32, hacc, lane);
            if (st.n + 1 == st.nch && st.sfin) {
#pragma unroll
                for (int g = 0; g < 4; ++g) *(f32x4*)(st.sfin + (size_t)(vb * 32 + l31) * 64 + tb * 32 + 8 * g + 4 * hh) = (f32x4){hacc[4 * g], hacc[4 * g + 1], hacc[4 * g + 2], hacc[4 * g + 3]};
            }
        }
        LDS_BAR();
        st = nx; have = nhave; u = nu;
    }
    if ((wave & 3) == 3) { TR_FINISH(); while (tslot * 2 < TR_ITEMS) { TR_START(); TR_FINISH(); } }
#undef TR_FINISH
#undef TR_START
#undef TR_ITEMS
}

namespace gd {
constexpr int P128 = 272, P64 = 144;
constexpr int O_K = 0, O_V = 17408, O_ST = 34816, O_QK = 69632, O_R1 = 78848, O_R2 = 97280, O_R3 = 115712, O_VEC = 134144, O_END = O_VEC + 1040;
constexpr int O_LOFF = O_R1, O_DD = O_R1 + 9216, O_VN = O_R1, O_Q = O_R2, O_WNEG = O_R2, O_LF = O_R3, O_NI = O_R3, O_N2I = O_R3 + 9216, O_TB = O_R3, O_TBG = O_R3 + 9216, O_VNS = O_R3, PLF = 272;
constexpr int V_GC = O_VEC, V_BETA = O_VEC + 256, V_EGC = O_VEC + 512, V_ELAST = O_VEC + 768, V_EGL = O_VEC + 1024;
static_assert(O_END <= 143360, "gdn chunk LDS map");
}
struct GdStep { int row0, T, h, d, n, nch; const float* sinit; float* sfin; };
__device__ __forceinline__ bool gd_unit(int u, GdStep& s, const float* state_gdn, float* GS) {
    if (u >= 2304) return false;
    if (u < 256) { const int bl = u >> 6, rem = u & 63; s.h = rem >> 1; s.d = rem & 1; s.row0 = MC + bl * 1024; s.T = 1024; s.nch = 16; s.sinit = state_gdn + ((size_t)(bl * 2 + s.d) * 32 + s.h) * 16384; s.sfin = nullptr; }
    else { const int ct = u - 256, b = ct >> 6, rem = ct & 63; s.h = rem >> 1; s.d = rem & 1; s.row0 = b * 256; s.T = 256; s.nch = 4; s.sinit = nullptr; s.sfin = GS + ((size_t)(b * 2 + s.d) * 32 + s.h) * 16384; }
    s.n = 0; return true;
}
__device__ __forceinline__ int gd_row(const GdStep& s, int tau) { const int tt = s.n * 64 + tau; return s.row0 + (s.d ? (s.T - 1 - tt) : tt); }

__device__ __forceinline__ void gdn_chunk_phase(LAS unsigned char* lds, int tid, int lane, int wave, int bx, int G, const bf16* QKVc, const float* GB, const float* state_gdn, float* GS, bf16* OF, bf16* OB) {
    using namespace gd;
    GdStep st; int u = bx;
    bool have = gd_unit(u, st, state_gdn, GS);
    const int lane_in = lane;
    v4u pq[2], pkk[2], pvv[2]; float pg = 0.f, pb = 0.f;
    if (have) {
#pragma unroll
        for (int e = 0; e < 2; ++e) { const int p = tid + 512 * e, r = p >> 4, ch = p & 15; const bf16* src = QKVc + (size_t)gd_row(st, r) * 12288 + st.h * 128 + ch * 8;
            pq[e] = *(const v4u*)src; pkk[e] = *(const v4u*)(src + 4096); pvv[e] = *(const v4u*)(src + 8192); }
        if (wave == 0) { const size_t o = (size_t)gd_row(st, lane) * 128 + st.d * 64 + st.h; pg = GB[o]; pb = GB[o + 32]; }
    }
    f32x16 sacc[2]; sacc[0] = zero16(); sacc[1] = zero16();
    const int ib = wave >> 2, vb = wave & 3;
    const int db = wave >> 1, vb2 = 2 * (wave & 1);
    while (have) {
        int lane = lane_in; asm volatile("" : "+v"(lane));
        const int hh = lane >> 5, l31 = lane & 31;
        if (st.n == 0) {
#pragma unroll
            for (int t = 0; t < 2; ++t) {
                if (st.sinit) {
#pragma unroll
                    for (int r = 0; r < 16; ++r) sacc[t][r] = st.sinit[(size_t)(db * 32 + crow(r, hh)) * 128 + (vb2 + t) * 32 + l31];
                } else sacc[t] = zero16();
                store_tile_T(lds + O_ST, P128, (vb2 + t) * 32, db * 32, sacc[t], lane);
            }
        }
#pragma unroll
        for (int e = 0; e < 2; ++e) { const int p = tid + 512 * e, r = p >> 4, ch = p & 15;
            *(LAS v4u*)(lds + O_Q + r * P128 + ch * 16) = pq[e]; *(LAS v4u*)(lds + O_K + r * P128 + ch * 16) = pkk[e]; *(LAS v4u*)(lds + O_V + r * P128 + ch * 16) = pvv[e]; }
        if (wave == 0) {
            const float x = wave_incl_scan_dpp(pg);
            const float glast = __builtin_bit_cast(float, __builtin_amdgcn_readlane(__builtin_bit_cast(int, x), 63));
            ((LAS float*)(lds + V_GC))[lane] = x; ((LAS float*)(lds + V_BETA))[lane] = pb; ((LAS float*)(lds + V_EGC))[lane] = __expf(x); ((LAS float*)(lds + V_ELAST))[lane] = __expf(glast - x);
            if (lane == 0) ((LAS float*)(lds + V_EGL))[0] = __expf(glast);
        }
        LDS_BAR();
        GdStep nx = st; bool nhave = true; int nu = u;
        if (st.n + 1 < st.nch) nx.n = st.n + 1; else { nu = u + G; nhave = gd_unit(nu, nx, state_gdn, GS); }
        if (nhave) {
#pragma unroll
            for (int e = 0; e < 2; ++e) { const int p = tid + 512 * e, r = p >> 4, ch = p & 15; const bf16* src = QKVc + (size_t)gd_row(nx, r) * 12288 + nx.h * 128 + ch * 8;
                pq[e] = *(const v4u*)src; pkk[e] = *(const v4u*)(src + 4096); pvv[e] = *(const v4u*)(src + 8192); }
            if (wave == 0) { const size_t o = (size_t)gd_row(nx, lane) * 128 + nx.d * 64 + nx.h; pg = GB[o]; pb = GB[o + 32]; }
        }
        {
            const int mat = wave >> 2, ib2 = (wave >> 1) & 1, jb = wave & 1;
            if (jb <= ib2) {
                f32x16 acc = zero16();
#pragma unroll
                for (int ks = 0; ks < 8; ++ks) acc = MFMA32(frag_row(lds + O_K, P128, jb * 32, ks, lane), frag_row(lds + (mat ? O_Q : O_K), P128, ib2 * 32, ks, lane), acc);
                const int i = ib2 * 32 + l31; const float gi = ((LAS float*)(lds + V_GC))[i]; const float bi = mat ? 1.f : ((LAS float*)(lds + V_BETA))[i];
                const bool diag = (jb == ib2);
#pragma unroll
                for (int g = 0; g < 4; ++g) { const f32x4 gj = *(const LAS f32x4*)(lds + V_GC + (jb * 32 + 8 * g + 4 * hh) * 4);
#pragma unroll
                    for (int e = 0; e < 4; ++e) { const int j = jb * 32 + 8 * g + 4 * hh + e; const bool keep = !diag || (mat ? (j <= i) : (j < i));
                        const float ex = __expf(fminf(gi - gj[e], 0.f)); acc[4 * g + e] = keep ? acc[4 * g + e] * ex * bi : 0.f; } }
                if (mat == 0) {
                    if (diag) {
#pragma unroll
                        for (int g = 0; g < 4; ++g) *(LAS f32x4*)(lds + O_LF + i * PLF + (jb * 32 + 8 * g + 4 * hh) * 4) = (f32x4){acc[4 * g], acc[4 * g + 1], acc[4 * g + 2], acc[4 * g + 3]};
#pragma unroll
                        for (int r = 0; r < 16; ++r) { const int j = jb * 32 + crow(r, hh); if ((j >> 4) == (i >> 4)) acc[r] = 0.f; }
                    }
                    store_tile_T(lds + O_LOFF, P64, ib2 * 32, jb * 32, acc, lane);
                } else store_tile_T(lds + O_QK, P64, ib2 * 32, jb * 32, acc, lane);
            }
        }
        LDS_BAR();
        if (wave == 3) inv_stepA(lds + O_LF, lds + O_DD, lane);
        asm volatile("" ::: "memory");
        f32x16 oacc = zero16(), isacc = zero16();
#define GD_QS() do { \
        _Pragma("unroll") for (int ks = 0; ks < 8; ++ks) oacc = MFMA32(frag_row(lds + O_ST, P128, vb * 32, ks, lane), frag_row(lds + O_Q, P128, ib * 32, ks, lane), oacc); \
        { const float eg = ((LAS float*)(lds + V_EGC))[ib * 32 + l31]; _Pragma("unroll") for (int r = 0; r < 16; ++r) oacc[r] *= eg; } } while (0)
        if (wave < 3) inv_zero_offdiag(lds + O_DD, wave + 1, lane);
        if (wave != 3) GD_QS();
        LDS_BAR();
        if (wave == 3) GD_QS();
        if (wave < 3) { const f32x16 p_ = ltri_tile_rt(lds + O_DD, lds + O_LOFF, wave, lane); ltri_store1(lds + O_NI, wave, p_, lane);
#pragma unroll
            for (int r = 0; r < 16; ++r) isacc[r] = ((wave != 1 && l31 == crow(r, hh)) ? 1.f : 0.f) - p_[r]; }
        LDS_BAR();
        if (wave < 3) { const f32x16 p_ = ltri_tile_rt(lds + O_NI, lds + O_NI, wave, lane); ltri_store1(lds + O_N2I, wave, p_, lane);
#pragma unroll
            for (int r = 0; r < 16; ++r) isacc[r] += p_[r]; }
        LDS_BAR();
        if (wave < 3) { const f32x16 p_ = ltri_tile_rt(lds + O_NI, lds + O_N2I, wave, lane);
#pragma unroll
            for (int r = 0; r < 16; ++r) isacc[r] -= p_[r];
            ltri_store1(lds + O_LOFF, wave, isacc, lane); }
        LDS_BAR();
        if (wave < 3) {
            const int nb = (wave == 2) ? 32 : 0; f32x16 tb_ = ltri_tile_rt(lds + O_LOFF, lds + O_DD, wave, lane), tg_ = tb_;
#pragma unroll
            for (int g = 0; g < 4; ++g) { const f32x4 bt = *(const LAS f32x4*)(lds + V_BETA + (nb + 8 * g + 4 * hh) * 4); const f32x4 eg = *(const LAS f32x4*)(lds + V_EGC + (nb + 8 * g + 4 * hh) * 4);
#pragma unroll
                for (int e = 0; e < 4; ++e) { tb_[4 * g + e] *= bt[e]; tg_[4 * g + e] *= bt[e] * eg[e]; } }
            ltri_store1(lds + O_TB, wave, tb_, lane); ltri_store1(lds + O_TBG, wave, tg_, lane);
        }
#undef GD_QS
        LDS_BAR();
        f32x16 uacc = zero16();
#pragma unroll
        for (int ks = 0; ks < 4; ++ks) { if (ks < 2 * (ib + 1)) uacc = MFMA32(frag_row(lds + O_TB, P64, ib * 32, ks, lane), frag_tr(lds + O_V, P128, 16 * ks, vb * 32, lane), uacc); }
        {
            const int ibw = wave & 1; f32x16 acc = zero16();
#pragma unroll
            for (int ks = 0; ks < 4; ++ks) { if (ks < 2 * (ibw + 1)) acc = MFMA32(frag_tr(lds + O_K, P128, 16 * ks, db * 32, lane), frag_row(lds + O_TBG, P64, ibw * 32, ks, lane), acc); }
#pragma unroll
            for (int r = 0; r < 16; ++r) acc[r] = -acc[r];
            store_tile_T(lds + O_WNEG, P128, ibw * 32, db * 32, acc, lane);
        }
        LDS_BAR();
#pragma unroll
        for (int ks = 0; ks < 8; ++ks) uacc = MFMA32(frag_row(lds + O_WNEG, P128, ib * 32, ks, lane), frag_row(lds + O_ST, P128, vb * 32, ks, lane), uacc);
        store_tile_T(lds + O_VN, P64, vb * 32, ib * 32, uacc, lane);
#pragma unroll
        for (int g = 0; g < 4; ++g) { const f32x4 el = *(const LAS f32x4*)(lds + V_ELAST + (ib * 32 + 8 * g + 4 * hh) * 4); uacc[4 * g] *= el.x; uacc[4 * g + 1] *= el.y; uacc[4 * g + 2] *= el.z; uacc[4 * g + 3] *= el.w; }
        store_tile_T(lds + O_VNS, P64, vb * 32, ib * 32, uacc, lane);
        LDS_BAR();
#pragma unroll
        for (int ks = 0; ks < 4; ++ks) { if (ks < 2 * (ib + 1)) oacc = MFMA32(frag_row(lds + O_VN, P64, vb * 32, ks, lane), frag_row(lds + O_QK, P64, ib * 32, ks, lane), oacc); }
        { bf16* Od = (st.d ? OB : OF) + (size_t)gd_row(st, ib * 32 + l31) * D + st.h * 128 + vb * 32 + 4 * hh;
#pragma unroll
          for (int g = 0; g < 4; ++g) { v2u w; w.x = cvtpk(oacc[4 * g], oacc[4 * g + 1]); w.y = cvtpk(oacc[4 * g + 2], oacc[4 * g + 3]); *(v2u*)(Od + 8 * g) = w; } }
        {
            const float egl = ((LAS float*)(lds + V_EGL))[0];
#pragma unroll
            for (int t = 0; t < 2; ++t)
#pragma unroll
                for (int r = 0; r < 16; ++r) sacc[t][r] *= egl;
#pragma unroll
            for (int ks = 0; ks < 4; ++ks) { const bf16x8 ka = frag_tr(lds + O_K, P128, 16 * ks, db * 32, lane);
                sacc[0] = MFMA32(ka, frag_row(lds + O_VNS, P64, vb2 * 32, ks, lane), sacc[0]); sacc[1] = MFMA32(ka, frag_row(lds + O_VNS, P64, (vb2 + 1) * 32, ks, lane), sacc[1]); }
            store_tile_T(lds + O_ST, P128, vb2 * 32, db * 32, sacc[0], lane); store_tile_T(lds + O_ST, P128, (vb2 + 1) * 32, db * 32, sacc[1], lane);
            if (st.n + 1 == st.nch && st.sfin) {
#pragma unroll
                for (int t = 0; t < 2; ++t)
#pragma unroll
                    for (int r = 0; r < 16; ++r) st.sfin[(size_t)(db * 32 + crow(r, hh)) * 128 + (vb2 + t) * 32 + l31] = sacc[t][r];
            }
        }
        LDS_BAR();
        st = nx; have = nhave; u = nu;
    }
}

struct MultiOrder {
    int G, c;
    int nA, nNA, pmStrideA, pnStrideA;
    int nB, pmBaseB, pnBaseB;
    int ntFull, ksplit;
    __device__ __forceinline__ bool next(int i, pg8::Unit& u) const {
        const int L = i * G + c; const int perA = NPAN * nNA, totA = nA * perA, perB = NPAN * ksplit;
        if (L >= totA + nB * perB) return false;
        int pm, pn, k0 = 0, nt = ntFull;
        if (L < totA) {
            const int g = L / perA; int wgid = L - g * perA;
            if (G == 256) {
                const int ii = wgid >> 8, cc = wgid & 255, xcd = cc & 7, j = cc >> 3, s = ii * 8 + xcd, ncb = nNA >> 2, grp = s / ncb, cb = s - grp * ncb;
                pm = g * pmStrideA + (NPAN / 8 - 1 - grp) * 8 + (j & 7);
                pn = g * pnStrideA + cb * 4 + (j >> 3);
            } else {
            { const int nwg = perA, q = nwg / 8, r = nwg % 8, xcd = wgid % 8, off = wgid / 8; wgid = (xcd < r ? xcd * (q + 1) : r * (q + 1) + (xcd - r) * q) + off; }
            const int nig = 8 * nNA, gid = wgid / nig, fm = gid * 8, gsz = (NPAN - fm) < 8 ? (NPAN - fm) : 8;
            pm = g * pmStrideA + fm + ((wgid % nig) % gsz); pn = g * pnStrideA + (wgid % nig) / gsz;
            }
        } else {
            const int l = L - totA; const int gB = l / perB, rem = l - gB * perB, pmm = rem / ksplit, kq = rem - pmm * ksplit;
            pm = pmBaseB + gB * NPAN + pmm; pn = pnBaseB + gB; nt = ntFull / ksplit; k0 = kq * nt * 64;
        }
        u = pg8::Unit{pm, pn, k0, nt}; return true;
    }
    __device__ __forceinline__ void a_ready(const pg8::Unit&) const {}
    __device__ __forceinline__ void done(const pg8::Unit&) const {}
};

typedef pg8::f32x4 A4;
__device__ __forceinline__ float red8(float v) { v += __shfl_xor(v, 1); v += __shfl_xor(v, 2); v += __shfl_xor(v, 4); return v; }
__device__ __forceinline__ void bf8(v4u w, f32x4& lo, f32x4& hi) { v2u a; a.x = w.x; a.y = w.y; lo = bf4(a); a.x = w.z; a.y = w.w; hi = bf4(a); }
__device__ __forceinline__ v4u pk8(f32x4 lo, f32x4 hi) { v4u r; r.x = pk2(lo.x, lo.y); r.y = pk2(lo.z, lo.w); r.z = pk2(hi.x, hi.y); r.w = pk2(hi.z, hi.w); return r; }
struct EpiP2 {
    static constexpr bool PERM = true, AFTER_DRAIN = false;
    bf16* RKVZ; bf16* MID;
    __device__ __forceinline__ void operator()(const A4 (&acc)[2][2][4][2], const pg8::Unit& u, int wr, int wc, int fr, int fq) const {
        if (u.pn < 64) {
            const int row0 = u.pm * 256 + wr * 64 + fr, col0 = (u.pn & 15) * 256 + wc * 32 + 8 * fq;
#pragma unroll
            for (int ai = 0; ai < 2; ++ai)
#pragma unroll
                for (int m = 0; m < 4; ++m) { bf16* rowp = RKVZ + (size_t)(row0 + ai * 128 + m * 16) * D + col0;
#pragma unroll
                    for (int bj = 0; bj < 2; ++bj) { const A4 v0 = acc[ai][bj][m][0], v1 = acc[ai][bj][m][1]; v4u w;
                        w.x = pg8::cvt_pk_bf16(v0[0], v0[1]); w.y = pg8::cvt_pk_bf16(v0[2], v0[3]); w.z = pg8::cvt_pk_bf16(v1[0], v1[1]); w.w = pg8::cvt_pk_bf16(v1[2], v1[3]);
                        __builtin_nontemporal_store(w, (v4u*)(rowp + bj * 128)); } }
        } else {
            const int g2 = u.pn - 64;
            const int row0 = (u.pm - (4 + g2) * NPAN) * 256 + wr * 64 + fr, col0 = wc * 32 + 8 * fq;
#pragma unroll
            for (int ai = 0; ai < 2; ++ai)
#pragma unroll
                for (int m = 0; m < 4; ++m)
#pragma unroll
                    for (int bj = 0; bj < 2; ++bj) { A4 v0 = acc[ai][bj][m][0], v1 = acc[ai][bj][m][1];
                        if (g2 == 0) { for (int e = 0; e < 4; ++e) { v0[e] = 1.f - 2.f * __builtin_amdgcn_rcpf(1.f + __expf(2.f * v0[e])); v1[e] = 1.f - 2.f * __builtin_amdgcn_rcpf(1.f + __expf(2.f * v1[e])); } }
                        v4u w; w.x = pg8::cvt_pk_bf16(v0[0], v0[1]); w.y = pg8::cvt_pk_bf16(v0[2], v0[3]); w.z = pg8::cvt_pk_bf16(v1[0], v1[1]); w.w = pg8::cvt_pk_bf16(v1[2], v1[3]);
                        *(v4u*)(MID + ((size_t)(g2 * 2 + bj) * M + row0 + ai * 128 + m * 16) * 128 + col0) = w; }
        }
    }
};
struct EpiP3 {
    static constexpr bool PERM = true, AFTER_DRAIN = false;
    bf16* LWIC; const float* w0; const float* a0;
    __device__ __forceinline__ void operator()(const A4 (&acc)[2][2][4][2], const pg8::Unit& u, int wr, int wc, int fr, int fq) const {
        const int gi = u.pn >> 4;
        const int row0 = u.pm * 256 + wr * 64 + fr, col0 = (u.pn & 15) * 256 + wc * 32 + 8 * fq;
        const float* bias = (gi < 2 ? w0 + gi * D : a0 + (gi - 2) * D) + col0; const float osc = gi < 2 ? -0.6065306597126334f : 1.f;
        A4 bv[2][2];
#pragma unroll
        for (int bj = 0; bj < 2; ++bj)
#pragma unroll
            for (int n = 0; n < 2; ++n) bv[bj][n] = *(const A4*)(bias + bj * 128 + 4 * n);
#pragma unroll
        for (int ai = 0; ai < 2; ++ai)
#pragma unroll
            for (int m = 0; m < 4; ++m) { bf16* rowp = LWIC + (size_t)(row0 + ai * 128 + m * 16) * D + col0;
#pragma unroll
                for (int bj = 0; bj < 2; ++bj) { A4 v0 = acc[ai][bj][m][0] + bv[bj][0], v1 = acc[ai][bj][m][1] + bv[bj][1];
                    for (int e = 0; e < 4; ++e) { v0[e] = osc * sigmoidf_(v0[e]); v1[e] = osc * sigmoidf_(v1[e]); }
                    v4u w; w.x = pg8::cvt_pk_bf16(v0[0], v0[1]); w.y = pg8::cvt_pk_bf16(v0[2], v0[3]); w.z = pg8::cvt_pk_bf16(v1[0], v1[1]); w.w = pg8::cvt_pk_bf16(v1[2], v1[3]);
                    *(v4u*)(rowp + bj * 128) = w; asm volatile("" ::: "memory"); }
                }
    }
};
template <bool SRC_BF16, bool OUT_BF16>
struct EpiRes {
    static constexpr bool PERM = true, AFTER_DRAIN = false;
    const void* srcC; const void* srcL;
    void* out; const float* mod;
    __device__ __forceinline__ void operator()(const A4 (&acc)[2][2][4][2], const pg8::Unit& u, int wr, int wc, int fr, int fq) const {
        const int row0 = u.pm * 256 + wr * 64 + fr, col0 = u.pn * 256 + wc * 32 + 8 * fq;
        const int j = u.pm < 32 ? 0 : 1 + ((u.pm - 32) >> 2);
        const float* gate = mod + (size_t)j * 12288 + 2 * D + col0;
        const size_t srow = u.pm < 32 ? (size_t)row0 : (size_t)(row0 - MC);
        const void* sbase = u.pm < 32 ? srcC : srcL;
        A4 gv[2][2];
#pragma unroll
        for (int bj = 0; bj < 2; ++bj)
#pragma unroll
            for (int n = 0; n < 2; ++n) gv[bj][n] = *(const A4*)(gate + bj * 128 + 4 * n);
#pragma unroll
        for (int ai = 0; ai < 2; ++ai)
#pragma unroll
            for (int m = 0; m < 4; ++m) { const size_t so = (srow + ai * 128 + m * 16) * D + col0, od = (size_t)(row0 + ai * 128 + m * 16) * D + col0;
#pragma unroll
                for (int bj = 0; bj < 2; ++bj) {
                    f32x4 xa, xb;
                    if (SRC_BF16) bf8(*(const v4u*)((const bf16*)sbase + so + bj * 128), xa, xb);
                    else { xa = *(const f32x4*)((const float*)sbase + so + bj * 128); xb = *(const f32x4*)((const float*)sbase + so + bj * 128 + 4); }
                    const A4 a0 = acc[ai][bj][m][0], a1 = acc[ai][bj][m][1]; const A4 g0 = gv[bj][0], g1 = gv[bj][1];
                    const f32x4 oa = xa + (f32x4){g0[0] * a0[0], g0[1] * a0[1], g0[2] * a0[2], g0[3] * a0[3]}, ob = xb + (f32x4){g1[0] * a1[0], g1[1] * a1[1], g1[2] * a1[2], g1[3] * a1[3]};
                    if (OUT_BF16) *(v4u*)((bf16*)out + od + bj * 128) = pk8(oa, ob);
                    else { *(f32x4*)((float*)out + od + bj * 128) = oa; *(f32x4*)((float*)out + od + bj * 128 + 4) = ob; }
                } }
    }
};
struct EpiP8 {
    static constexpr bool PERM = true, AFTER_DRAIN = false;
    bf16* QKVZ; float* AB;
    __device__ __forceinline__ void operator()(const A4 (&acc)[2][2][4][2], const pg8::Unit& u, int wr, int wc, int fr, int fq) const {
        const int row0 = u.pm * 256 + wr * 64 + fr;
        if (u.pn < 64) {
            const int col0 = u.pn * 256 + wc * 32 + 8 * fq;
#pragma unroll
            for (int ai = 0; ai < 2; ++ai)
#pragma unroll
                for (int m = 0; m < 4; ++m) { bf16* rowp = QKVZ + (size_t)(row0 + ai * 128 + m * 16) * 16384 + col0;
#pragma unroll
                    for (int bj = 0; bj < 2; ++bj) { const A4 v0 = acc[ai][bj][m][0], v1 = acc[ai][bj][m][1]; v4u w;
                        w.x = pg8::cvt_pk_bf16(v0[0], v0[1]); w.y = pg8::cvt_pk_bf16(v0[2], v0[3]); w.z = pg8::cvt_pk_bf16(v1[0], v1[1]); w.w = pg8::cvt_pk_bf16(v1[2], v1[3]);
                        __builtin_nontemporal_store(w, (v4u*)(rowp + bj * 128)); } }
        } else {
            const int col0 = wc * 32 + 8 * fq; float* ABq = AB + (size_t)(u.k0 >> 10) * M * 128;
#pragma unroll
            for (int ai = 0; ai < 2; ++ai)
#pragma unroll
                for (int m = 0; m < 4; ++m) { float* rowp = ABq + (size_t)(row0 + ai * 128 + m * 16) * 128 + col0;
                    *(A4*)(rowp) = acc[ai][0][m][0]; *(A4*)(rowp + 4) = acc[ai][0][m][1]; }
        }
    }
};

__device__ __forceinline__ const float* xrow(const float* xp, const float* xs, int m) { return m < MC ? xp + (size_t)m * D : xs + (size_t)(m - MC) * D; }
__device__ __forceinline__ float red16(float v) { v += __shfl_xor(v, 1); v += __shfl_xor(v, 2); v += __shfl_xor(v, 4); v += __shfl_xor(v, 8); return v; }
__device__ __forceinline__ float red32(float v) { v = red16(v); v += __shfl_xor(v, 16); return v; }
__device__ __forceinline__ float sum4(f32x4 v) { return (v.x + v.y) + (v.z + v.w); }

__device__ __forceinline__ void p0_mod(LAS unsigned char* lds, const float* c, const float* c_ctx, const float* ada_w, const float* ada_b, float* MOD, int tid, int lane, int wave, int G) {
    LAS float* tab = (LAS float*)lds;
    LAS float* red = (LAS float*)(lds + 81920);
    for (int i = tid; i < 5 * D; i += NWAVES * 64) { const int j = i / D, k = i % D; const float cv = (j == 0) ? c_ctx[k] : c[(j - 1) * D + k]; tab[i] = siluf_(cv); }
    __syncthreads();
    for (int item = blockIdx.x; item < 192; item += G) {
        const int L = item / 96, cb = item % 96, half = lane >> 5;
        const float* W = ada_w + (size_t)L * D * 12288 + cb * 128 + (lane & 31) * 4;
        f32x4 acc[5];
#pragma unroll
        for (int j = 0; j < 5; ++j) acc[j] = (f32x4){0.f, 0.f, 0.f, 0.f};
        const int kb = wave * 512 + half;
#pragma unroll 8
        for (int kk = 0; kk < 256; ++kk) { const int k = kb + 2 * kk; const f32x4 w = __builtin_nontemporal_load((const f32x4*)(W + (size_t)k * 12288));
#pragma unroll
            for (int j = 0; j < 5; ++j) acc[j] += tab[j * D + k] * w; }
#pragma unroll
        for (int j = 0; j < 5; ++j) { acc[j].x += __shfl_xor(acc[j].x, 32); acc[j].y += __shfl_xor(acc[j].y, 32); acc[j].z += __shfl_xor(acc[j].z, 32); acc[j].w += __shfl_xor(acc[j].w, 32); }
        if (half == 0) {
#pragma unroll
            for (int j = 0; j < 5; ++j) *(LAS f32x4*)(red + (wave * 5 + j) * 128 + (lane & 31) * 4) = acc[j];
        }
        __syncthreads();
        for (int i = tid; i < 640; i += NWAVES * 64) { const int j = i / 128, col = i % 128; float s = 0.f;
#pragma unroll
            for (int w = 0; w < 8; ++w) s += red[(w * 5 + j) * 128 + col];
            const int gc = cb * 128 + col; MOD[(size_t)(L * 5 + j) * 12288 + gc] = s + ada_b[(size_t)L * 12288 + gc]; }
        __syncthreads();
    }
    __syncthreads();
}
__device__ __forceinline__ void rstd_rows(const float* xp, const float* xs, float* RSTD, int gw, int NGW, int lane) {
    for (int m = gw; m < M; m += NGW) { const f32x4* xr = (const f32x4*)xrow(xp, xs, m) + lane; float s = 0.f;
#pragma unroll
        for (int j = 0; j < 16; ++j) { const f32x4 v = xr[64 * j]; s += (v.x * v.x + v.y * v.y) + (v.z * v.z + v.w * v.w); }
        s = wave_sum(s); if (lane == 0) RSTD[m] = rsqrtf(s * (1.f / D) + 1e-6f); }
}
__device__ __forceinline__ int p1_nbr(int m, int q, int& j) {
    if (m < MC) { const int t = m & 255; j = 0; return (q < 2) ? (t > 0 ? m - 1 : -1) : (t < 255 ? m + 1 : -1); }
    const int ml = m - MC, t = ml & 1023, gc = t & 63, gr = t >> 6; j = 1 + (ml >> 10);
    return q == 0 ? (gc > 0 ? m - 1 : -1) : (q == 1 ? (gc < 63 ? m + 1 : -1) : (q == 2 ? (gr > 0 ? m - 64 : -1) : (gr < 15 ? m + 64 : -1)));
}
__device__ __forceinline__ void p1_mix(const float* xp, const float* xs, const float* RSTD, const float* mod0, const float* nw, const float* mu, bf16* XMIX, int gw, int NGW, int lane) {
    const f32x4 z4 = (f32x4){0.f, 0.f, 0.f, 0.f};
    for (int task = gw; task < 2048; task += NGW) {
        const int it = task & 7, rg = task >> 3, c = it * 512 + lane * 8, q = it >> 1, m0 = rg * 48;
        const f32x4 nwa = *(const f32x4*)(nw + c), nwb = *(const f32x4*)(nw + c + 4); f32x4 mua[6], mub[6];
#pragma unroll
        for (int p = 0; p < 6; ++p) { mua[p] = *(const f32x4*)(mu + p * D + c); mub[p] = *(const f32x4*)(mu + p * D + c + 4); }
        f32x4 XA[4], XB[4], NA[4], NB[4];
#pragma unroll
        for (int r = 0; r < 4; ++r) { const int m = m0 + r; int j; const int n = p1_nbr(m, q, j); const float* xr = xrow(xp, xs, m) + c; XA[r] = *(const f32x4*)xr; XB[r] = *(const f32x4*)(xr + 4);
            NA[r] = z4; NB[r] = z4; if (n >= 0) { const float* xn = xrow(xp, xs, n) + c; NA[r] = *(const f32x4*)xn; NB[r] = *(const f32x4*)(xn + 4); } }
#pragma unroll 1
        for (int b = 0; b < 12; ++b) {
            f32x4 PXA[4], PXB[4], PNA[4], PNB[4];
#pragma unroll
            for (int r = 0; r < 4; ++r) { PXA[r] = z4; PXB[r] = z4; PNA[r] = z4; PNB[r] = z4;
                if (b < 11) { const int m = m0 + 4 * (b + 1) + r; int j; const int n = p1_nbr(m, q, j); const float* xr = xrow(xp, xs, m) + c; PXA[r] = *(const f32x4*)xr; PXB[r] = *(const f32x4*)(xr + 4);
                    if (n >= 0) { const float* xn = xrow(xp, xs, n) + c; PNA[r] = *(const f32x4*)xn; PNB[r] = *(const f32x4*)(xn + 4); } } }
#pragma unroll
            for (int r = 0; r < 4; ++r) {
                const int m = m0 + 4 * b + r; int j; const int n = p1_nbr(m, q, j);
                const float* sh = mod0 + (size_t)j * 12288 + c; const float* sc = sh + D; const float rs = RSTD[m];
                const f32x4 aa = nwa * (1.f + *(const f32x4*)sc), ab = nwb * (1.f + *(const f32x4*)(sc + 4)), sa = *(const f32x4*)sh, sb = *(const f32x4*)(sh + 4);
                const f32x4 ha = XA[r] * rs * aa + sa, hb = XB[r] * rs * ab + sb; f32x4 hsa = z4, hsb = z4;
                if (n >= 0) { const float rn = RSTD[n]; hsa = NA[r] * rn * aa + sa; hsb = NB[r] * rn * ab + sb; }
                const f32x4 xa = hsa - ha, xb = hsb - hb;
#pragma unroll
                for (int p = 0; p < 6; ++p) *(v4u*)(XMIX + ((size_t)p * M + m) * D + c) = pk8(ha + xa * mua[p], hb + xb * mub[p]);
            }
#pragma unroll
            for (int r = 0; r < 4; ++r) { XA[r] = PXA[r]; XB[r] = PXB[r]; NA[r] = PNA[r]; NB[r] = PNB[r]; }
        }
    }
}
__device__ __forceinline__ void rwkv_seq(LAS float* wl, int lane, int row0, int T, int h, int d, const bf16* RKVZ, const bf16* LWIC, const float* k_k, const float* k_a,
                                         const float* sinit, float* sfin, float* Yd) {
    float S[64];
    if (sinit) {
#pragma unroll
        for (int k4 = 0; k4 < 16; ++k4) { const f32x4 v = *(const f32x4*)(sinit + lane * 64 + 4 * k4); S[4 * k4] = v.x; S[4 * k4 + 1] = v.y; S[4 * k4 + 2] = v.z; S[4 * k4 + 3] = v.w; }
    } else {
#pragma unroll
        for (int k = 0; k < 64; ++k) S[k] = 0.f;
    }
    const int c = h * 64 + lane; const float kkc = k_k[c], kac = k_a[c];
#pragma unroll 1
    for (int t0 = 0; t0 < T; t0 += 8) {
#pragma unroll
        for (int i = 0; i < 8; ++i) {
            const int tt = t0 + i, t = d ? (T - 1 - tt) : tt; const size_t row = (size_t)(row0 + t);
            const float rf = bf2f(RKVZ[((size_t)0 * M + row) * D + c]), kf = bf2f(RKVZ[((size_t)1 * M + row) * D + c]), vf = bf2f(RKVZ[((size_t)2 * M + row) * D + c]);
            const float lw = bf2f(LWIC[((size_t)d * M + row) * D + c]), ic = bf2f(LWIC[((size_t)(2 + d) * M + row) * D + c]);
            const float kkv = kf * kkc; const float nrm = wave_sum(kkv * kkv); const float kk = kkv * rsqrtf(nrm + 1e-6f);
            LAS float* p = wl + i * 384;
            p[lane] = __expf(lw); p[64 + lane] = kk; p[128 + lane] = kk * ic; p[192 + lane] = kf * (1.f + (ic - 1.f) * kac); p[256 + lane] = rf; p[320 + lane] = vf;
        }
        LDS_WAIT();
#pragma unroll 1
        for (int i = 0; i < 8; ++i) {
            const LAS f32x4* W4 = (const LAS f32x4*)(wl + i * 384); const LAS f32x4* KK4 = W4 + 16; const LAS f32x4* B4 = W4 + 32; const LAS f32x4* KT4 = W4 + 48; const LAS f32x4* R4 = W4 + 64;
            const float vv = wl[i * 384 + 320 + lane];
            float d0 = 0.f, d1 = 0.f, d2 = 0.f, d3 = 0.f;
#pragma unroll
            for (int k4 = 0; k4 < 16; ++k4) { const f32x4 q = KK4[k4]; d0 += S[4 * k4] * q.x; d1 += S[4 * k4 + 1] * q.y; d2 += S[4 * k4 + 2] * q.z; d3 += S[4 * k4 + 3] * q.w; }
            const float dot = (d0 + d1) + (d2 + d3);
            float y0 = 0.f, y1 = 0.f, y2 = 0.f, y3 = 0.f;
#pragma unroll
            for (int k4 = 0; k4 < 16; ++k4) { const f32x4 w4 = W4[k4], b4 = B4[k4], t4 = KT4[k4], r4 = R4[k4];
                float s;
                s = S[4 * k4] * w4.x + (vv * t4.x - dot * b4.x); S[4 * k4] = s; y0 += s * r4.x;
                s = S[4 * k4 + 1] * w4.y + (vv * t4.y - dot * b4.y); S[4 * k4 + 1] = s; y1 += s * r4.y;
                s = S[4 * k4 + 2] * w4.z + (vv * t4.z - dot * b4.z); S[4 * k4 + 2] = s; y2 += s * r4.z;
                s = S[4 * k4 + 3] * w4.w + (vv * t4.w - dot * b4.w); S[4 * k4 + 3] = s; y3 += s * r4.w; }
            const int tt = t0 + i, t = d ? (T - 1 - tt) : tt;
            Yd[(size_t)(row0 + t) * D + c] = (y0 + y1) + (y2 + y3);
        }
    }
    if (sfin) {
#pragma unroll
        for (int k4 = 0; k4 < 16; ++k4) *(f32x4*)(sfin + lane * 64 + 4 * k4) = (f32x4){S[4 * k4], S[4 * k4 + 1], S[4 * k4 + 2], S[4 * k4 + 3]};
    }
}
__device__ __forceinline__ void p5_post(const bf16* YF, const bf16* YB, const bf16* RKVZ, const bf16* LWIC, const float* ln_w, const float* ln_b, const float* k_a, const float* r_k, bf16* Gout, int gw, int NGW, int lane) {
    for (int task = gw; task < 2048; task += NGW) {
        const int it = task & 7, rg = task >> 3, c = it * 512 + lane * 8;
        const f32x4 lwa = *(const f32x4*)(ln_w + c), lwb = *(const f32x4*)(ln_w + c + 4), lba = *(const f32x4*)(ln_b + c), lbb = *(const f32x4*)(ln_b + c + 4);
        const f32x4 kaa = *(const f32x4*)(k_a + c), kab = *(const f32x4*)(k_a + c + 4), r0a = *(const f32x4*)(r_k + c), r0b = *(const f32x4*)(r_k + c + 4), r1a = *(const f32x4*)(r_k + D + c), r1b = *(const f32x4*)(r_k + D + c + 4);
        v4u cur[2][8], nxt[2][8];
#define NTL(p_) __builtin_nontemporal_load((const v4u*)(p_))
#define P5_LOAD(dst, m_) do { const size_t o_ = (size_t)(m_) * D + c; dst[0] = NTL(YF + o_); dst[1] = NTL(YB + o_); dst[2] = NTL(RKVZ + o_); dst[3] = NTL(RKVZ + (size_t)M * D + o_); \
            dst[4] = NTL(RKVZ + (size_t)2 * M * D + o_); dst[5] = NTL(RKVZ + (size_t)3 * M * D + o_); dst[6] = NTL(LWIC + (size_t)2 * M * D + o_); dst[7] = NTL(LWIC + (size_t)3 * M * D + o_); } while (0)
        P5_LOAD(cur[0], rg * 48); P5_LOAD(cur[1], rg * 48 + 1);
#pragma unroll 1
        for (int b = 0; b < 24; ++b) {
            const int mn = rg * 48 + 2 * (b + 1) < M - 1 ? rg * 48 + 2 * (b + 1) : M - 2;
            P5_LOAD(nxt[0], mn); P5_LOAD(nxt[1], mn + 1);
#pragma unroll
            for (int r = 0; r < 2; ++r) {
                const int m = rg * 48 + 2 * b + r; const size_t o = (size_t)m * D + c;
                f32x4 ya, yb, ta, tb; bf8(cur[r][0], ya, yb); bf8(cur[r][1], ta, tb); ya = ya + ta; yb = yb + tb;
                const float mean = red8(sum4(ya) + sum4(yb)) * (1.f / 64.f); const f32x4 da = ya - mean, db = yb - mean;
                const float var = red8(sum4(da * da) + sum4(db * db)) * (1.f / 64.f); const float rinv = rsqrtf(var + 64e-5f);
                const f32x4 yna = da * rinv * lwa + lba, ynb = db * rinv * lwb + lbb;
                f32x4 ra, rb, ka, kb, va, vb, za, zb, i0a, i0b, i1a, i1b;
                bf8(cur[r][2], ra, rb); bf8(cur[r][3], ka, kb); bf8(cur[r][4], va, vb); bf8(cur[r][5], za, zb); bf8(cur[r][6], i0a, i0b); bf8(cur[r][7], i1a, i1b);
                const f32x4 t0a = ka * (1.f + (i0a - 1.f) * kaa), t0b = kb * (1.f + (i0b - 1.f) * kab), t1a = ka * (1.f + (i1a - 1.f) * kaa), t1b = kb * (1.f + (i1b - 1.f) * kab);
                const float bonus = red8(sum4(ra * (t0a * r0a + t1a * r1a)) + sum4(rb * (t0b * r0b + t1b * r1b)));
                *(v4u*)(Gout + o) = pk8((yna + bonus * va) * silu4(za), (ynb + bonus * vb) * silu4(zb));
            }
#pragma unroll
            for (int r = 0; r < 2; ++r)
#pragma unroll
                for (int k = 0; k < 8; ++k) cur[r][k] = nxt[r][k];
        }
#undef P5_LOAD
#undef NTL
    }
}
__device__ __forceinline__ void p7_norm(const float* X1, const float* mod1, const float* nw, bf16* H1, int gw, int NGW, int lane) {
    for (int m = gw; m < M; m += NGW) {
        const int j = m < MC ? 0 : 1 + ((m - MC) >> 10); const float* sh = mod1 + (size_t)j * 12288; const float* sc = sh + D;
        const f32x4* xr = (const f32x4*)(X1 + (size_t)m * D) + lane; f32x4 v[16]; float s = 0.f;
#pragma unroll
        for (int jj = 0; jj < 16; ++jj) { v[jj] = xr[64 * jj]; s += sum4(v[jj] * v[jj]); }
        const float rs = rsqrtf(wave_sum(s) * (1.f / D) + 1e-6f);
#pragma unroll
        for (int jj = 0; jj < 16; ++jj) { const int c = jj * 256 + lane * 4; const f32x4 a4 = *(const f32x4*)(nw + c) * (1.f + *(const f32x4*)(sc + c));
            *(v2u*)(H1 + (size_t)m * D + c) = pk4(v[jj] * rs * a4 + *(const f32x4*)(sh + c)); }
    }
}
__device__ __forceinline__ void p9_prep(const bf16* QKVZ, const float* AB, const float* conv, const float* A_log, const float* dt_bias, bf16* QKVc, float* GB, int gw, int NGW, int lane) {
    for (int task = gw; task < 24 * 256; task += NGW) {
        const int it = task % 24, rg = task / 24, c = it * 512 + lane * 8;
        const f32x4 w0a = *(const f32x4*)(conv + c), w0b = *(const f32x4*)(conv + c + 4), w1a = *(const f32x4*)(conv + 12288 + c), w1b = *(const f32x4*)(conv + 12288 + c + 4), w2a = *(const f32x4*)(conv + 2 * 12288 + c), w2b = *(const f32x4*)(conv + 2 * 12288 + c + 4);
        const float qs = it < 8 ? 0.08838834764831845f : 1.f;
        const int m0 = rg * 48; const bf16* base = QKVZ + (size_t)(m0 - 1) * 16384 + c;
        v4u w[10];
#pragma unroll
        for (int j = 0; j < 10; ++j) { w[j] = (v4u){0u, 0u, 0u, 0u}; if (m0 - 1 + j >= 0 && m0 - 1 + j < M) w[j] = *(const v4u*)(base + (size_t)j * 16384); }
#pragma unroll 1
        for (int b = 0; b < 6; ++b) {
            v4u nx[8];
#pragma unroll
            for (int k = 0; k < 8; ++k) { const int j = 8 * b + 10 + k; nx[k] = (v4u){0u, 0u, 0u, 0u}; if (b < 5 && m0 - 1 + j < M) nx[k] = *(const v4u*)(base + (size_t)j * 16384); }
#pragma unroll
            for (int r = 0; r < 8; ++r) {
                const int m = m0 + 8 * b + r; int t, T; if (m < MC) { t = m & 255; T = 256; } else { t = (m - MC) & 1023; T = 1024; }
                f32x4 x1a, x1b, x0a, x0b, x2a, x2b; bf8(w[r + 1], x1a, x1b); bf8(w[r], x0a, x0b); bf8(w[r + 2], x2a, x2b);
                if (t == 0) { x0a = (f32x4){0.f, 0.f, 0.f, 0.f}; x0b = x0a; }
                if (t == T - 1) { x2a = (f32x4){0.f, 0.f, 0.f, 0.f}; x2b = x2a; }
                f32x4 ya = silu4(w0a * x0a + w1a * x1a + w2a * x2a), yb = silu4(w0b * x0b + w1b * x1b + w2b * x2b);
                if (it < 16) { const float ss = red16(sum4(ya * ya) + sum4(yb * yb)); const float scl = rsqrtf(ss + 1e-6f) * qs; ya = ya * scl; yb = yb * scl; }
                *(v4u*)(QKVc + (size_t)m * 12288 + c) = pk8(ya, yb);
            }
            w[0] = w[8]; w[1] = w[9];
#pragma unroll
            for (int k = 0; k < 8; ++k) w[2 + k] = nx[k];
        }
    }
    for (int m = gw; m < M; m += NGW) {
        const int dir = lane >> 5, hh = lane & 31; float a = 0.f, b = 0.f;
#pragma unroll
        for (int kq = 0; kq < 4; ++kq) { a += AB[((size_t)kq * M + m) * 128 + dir * 64 + hh]; b += AB[((size_t)kq * M + m) * 128 + dir * 64 + 32 + hh]; }
        GB[(size_t)m * 128 + dir * 64 + hh] = -__expf(A_log[dir * 32 + hh]) * softplusf_(a + dt_bias[dir * 32 + hh]);
        GB[(size_t)m * 128 + dir * 64 + 32 + hh] = sigmoidf_(b);
    }
}
__device__ __forceinline__ void gdn_seq(LAS float* wl, int lane, int row0, int T, int h, int d, int hv, const bf16* QKVc, const float* GB, const float* sinit, float* sfin, float* Od) {
    float S[128];
    const int vc = hv * 64 + lane;
    if (sinit) {
#pragma unroll
        for (int k = 0; k < 128; ++k) S[k] = sinit[k * 128 + vc];
    } else {
#pragma unroll
        for (int k = 0; k < 128; ++k) S[k] = 0.f;
    }
#pragma unroll 1
    for (int t0 = 0; t0 < T; t0 += 8) {
#pragma unroll
        for (int i = 0; i < 8; ++i) {
            const int tt = t0 + i, t = d ? (T - 1 - tt) : tt; const size_t row = (size_t)(row0 + t);
            const unsigned q2 = *(const unsigned*)(QKVc + row * 12288 + h * 128 + lane * 2), k2 = *(const unsigned*)(QKVc + row * 12288 + 4096 + h * 128 + lane * 2);
            const float vf = bf2f(QKVc[row * 12288 + 8192 + h * 128 + vc]);
            LAS float* p = wl + i * 384;
            p[2 * lane] = __builtin_bit_cast(float, q2 << 16); p[2 * lane + 1] = __builtin_bit_cast(float, q2 & 0xffff0000u);
            p[128 + 2 * lane] = __builtin_bit_cast(float, k2 << 16); p[128 + 2 * lane + 1] = __builtin_bit_cast(float, k2 & 0xffff0000u);
            p[256 + lane] = vf;
            if (lane == 0) { p[320] = __expf(GB[row * 128 + d * 64 + h]); p[321] = GB[row * 128 + d * 64 + 32 + h]; }
        }
        LDS_WAIT();
#pragma unroll 1
        for (int i = 0; i < 8; ++i) {
            const LAS f32x4* Q4 = (const LAS f32x4*)(wl + i * 384); const LAS f32x4* K4 = Q4 + 32;
            const float vv = wl[i * 384 + 256 + lane], a = wl[i * 384 + 320], beta = wl[i * 384 + 321];
            float d0 = 0.f, d1 = 0.f, d2 = 0.f, d3 = 0.f;
#pragma unroll
            for (int k4 = 0; k4 < 32; ++k4) { const f32x4 q = K4[k4]; d0 += S[4 * k4] * q.x; d1 += S[4 * k4 + 1] * q.y; d2 += S[4 * k4 + 2] * q.z; d3 += S[4 * k4 + 3] * q.w;
                if ((k4 & 7) == 7) asm volatile("" ::: "memory"); }
            const float dot = (d0 + d1) + (d2 + d3);
            const float cc = beta * (vv - a * dot);
            float y0 = 0.f, y1 = 0.f, y2 = 0.f, y3 = 0.f;
#pragma unroll
            for (int k4 = 0; k4 < 32; ++k4) { const f32x4 kq = K4[k4], qq = Q4[k4];
                float s;
                s = a * S[4 * k4] + cc * kq.x; S[4 * k4] = s; y0 += s * qq.x;
                s = a * S[4 * k4 + 1] + cc * kq.y; S[4 * k4 + 1] = s; y1 += s * qq.y;
                s = a * S[4 * k4 + 2] + cc * kq.z; S[4 * k4 + 2] = s; y2 += s * qq.z;
                s = a * S[4 * k4 + 3] + cc * kq.w; S[4 * k4 + 3] = s; y3 += s * qq.w;
                if ((k4 & 3) == 3) asm volatile("" ::: "memory"); }
            const int tt = t0 + i, t = d ? (T - 1 - tt) : tt;
            Od[(size_t)(row0 + t) * D + h * 128 + vc] = (y0 + y1) + (y2 + y3);
        }
    }
    if (sfin) {
#pragma unroll
        for (int k = 0; k < 128; ++k) sfin[k * 128 + vc] = S[k];
    }
}
__device__ __forceinline__ void p11_post(const bf16* OF, const bf16* OB, const bf16* QKVZ, const float* gnw, bf16* G2, int gw, int NGW, int lane) {
    for (int task = gw; task < 2048; task += NGW) {
        const int it = task & 7, rg = task >> 3, c = it * 512 + lane * 8;
        const f32x4 ga = *(const f32x4*)(gnw + (lane & 15) * 8), gb = *(const f32x4*)(gnw + (lane & 15) * 8 + 4);
#pragma unroll 4
        for (int r = 0; r < 48; ++r) {
            const int m = rg * 48 + r; const size_t o = (size_t)m * D + c;
            f32x4 ya, yb, ta, tb, za, zb; bf8(__builtin_nontemporal_load((const v4u*)(OF + o)), ya, yb); bf8(__builtin_nontemporal_load((const v4u*)(OB + o)), ta, tb); ya = ya + ta; yb = yb + tb;
            const float ms = red16(sum4(ya * ya) + sum4(yb * yb)) * (1.f / 128.f); const float rinv = rsqrtf(ms + 1e-6f);
            bf8(__builtin_nontemporal_load((const v4u*)(QKVZ + (size_t)m * 16384 + 12288 + c)), za, zb);
            *(v4u*)(G2 + o) = pk8(ya * rinv * ga * silu4(za), yb * rinv * gb * silu4(zb));
        }
    }
}
__device__ __forceinline__ void p13_final(float* Y, const float* fw, int gw, int NGW, int lane) {
    for (int m = gw; m < M; m += NGW) {
        f32x4* xr = (f32x4*)(Y + (size_t)m * D) + lane; f32x4 v[16]; float s = 0.f;
#pragma unroll
        for (int jj = 0; jj < 16; ++jj) { v[jj] = xr[64 * jj]; s += sum4(v[jj] * v[jj]); }
        const float rs = rsqrtf(wave_sum(s) * (1.f / D) + 1e-6f);
#pragma unroll
        for (int jj = 0; jj < 16; ++jj) xr[64 * jj] = v[jj] * rs * *(const f32x4*)(fw + jj * 256 + lane * 4);
    }
}

template <int MODE, bool IN_BF16 = false>
__device__ __forceinline__ void norm8_block(LAS unsigned char* lds, const float* xp, const float* xs, float* RSTD, const float* mod, const float* nw, bf16* H1, float* Yio, int bx, int G, int wave, int lane) {
    LAS float* red = (LAS float*)lds;
    const int c0 = wave * 512 + lane * 8, c1 = c0 + 4;
    f32x4 p0 = (f32x4){0.f, 0.f, 0.f, 0.f}, p1 = p0;
    if (MODE != 0) { p0 = *(const f32x4*)(nw + c0); p1 = *(const f32x4*)(nw + c1); }
    int par = 0;
    for (int grp = bx; grp < M / 8; grp += G, par ^= 1) {
        const int m0 = grp * 8;
        f32x4 v[8][2];
#pragma unroll
        for (int r = 0; r < 8; ++r) {
            if (IN_BF16) bf8(__builtin_nontemporal_load((const v4u*)((const bf16*)xp + (size_t)(m0 + r) * D + c0)), v[r][0], v[r][1]);
            else { const float* xr = (MODE == 2) ? Yio + (size_t)(m0 + r) * D : xrow(xp, xs, m0 + r); v[r][0] = *(const f32x4*)(xr + c0); v[r][1] = *(const f32x4*)(xr + c1); } }
#pragma unroll
        for (int r = 0; r < 8; ++r) { const float s = wave_sum_dpp(sum4(v[r][0] * v[r][0]) + sum4(v[r][1] * v[r][1])); if (lane == 0) red[(par * 8 + r) * 8 + wave] = s; }
        LDS_BAR();
        f32x4 a0 = p0, a1 = p1, s0 = (f32x4){0.f, 0.f, 0.f, 0.f}, s1 = s0;
        if (MODE == 1) { const int j = m0 < MC ? 0 : 1 + ((m0 - MC) >> 10); const float* sh = mod + (size_t)j * 12288; const float* sc = sh + D;
            a0 = p0 * (1.f + *(const f32x4*)(sc + c0)); a1 = p1 * (1.f + *(const f32x4*)(sc + c1)); s0 = *(const f32x4*)(sh + c0); s1 = *(const f32x4*)(sh + c1); }
#pragma unroll
        for (int r = 0; r < 8; ++r) {
            const LAS f32x4* rr = (const LAS f32x4*)(red + (par * 8 + r) * 8); const f32x4 ra = rr[0], rb = rr[1];
            const float rs = rsqrtf((sum4(ra) + sum4(rb)) * (1.f / D) + 1e-6f);
            if (MODE == 0) { if (wave == 0 && lane == 0) RSTD[m0 + r] = rs; }
            else if (MODE == 1) { bf16* o = H1 + (size_t)(m0 + r) * D; *(v4u*)(o + c0) = pk8(v[r][0] * rs * a0 + s0, v[r][1] * rs * a1 + s1); }
            else { float* o = Yio + (size_t)(m0 + r) * D; *(f32x4*)(o + c0) = v[r][0] * rs * a0; *(f32x4*)(o + c1) = v[r][1] * rs * a1; }
        }
    }
    LDS_BAR();
}

struct Args { const float* in[31]; float* out; unsigned char* ws; int ph_lo, ph_hi; };
__global__ void __launch_bounds__(NWAVES * 64, 2) mk_fwd(Args args) {
    extern __shared__ __attribute__((aligned(16))) unsigned char lds_raw[];
    LAS unsigned char* lds = (LAS unsigned char*)lds_raw;
    volatile LAS unsigned* MISC = (volatile LAS unsigned*)(lds + MISC_OFF);
    const int tid = threadIdx.x, lane = tid & 63, wave = __builtin_amdgcn_readfirstlane(tid >> 6);
    const int G = gridDim.x; const int bx = blockIdx.x;
    const int gw = bx * NWAVES + wave, NGW = G * NWAVES;
    unsigned char* ws = args.ws; float* out = args.out;
    gu32* ctl = (gu32*)(ws + WS_CTL);
    const float* x_prompt = args.in[0]; const float* x_sample = args.in[1]; const float* state_rwkv = args.in[2]; const float* state_gdn = args.in[3];
    const float* c_in = args.in[4]; const float* c_ctx = args.in[5]; const float* ada_w = args.in[6]; const float* ada_b = args.in[7];
    const float* norm_w = args.in[8]; const float* final_norm_w = args.in[9]; const float* rwkv_mu = args.in[10]; const float* rwkv_w_in = args.in[11];
    const float* rwkv_w0 = args.in[12]; const float* rwkv_w1 = args.in[13]; const float* rwkv_w2 = args.in[14]; const float* rwkv_a0 = args.in[15];
    const float* rwkv_a1 = args.in[16]; const float* rwkv_a2 = args.in[17]; const float* rwkv_k_k = args.in[18]; const float* rwkv_k_a = args.in[19];
    const float* rwkv_r_k = args.in[20]; const float* rwkv_ln_w = args.in[21]; const float* rwkv_ln_b = args.in[22]; const float* rwkv_w_out = args.in[23];
    const float* gdn_w_in = args.in[24]; const float* gdn_conv = args.in[25]; const float* gdn_w_ab = args.in[26]; const float* gdn_A_log = args.in[27];
    const float* gdn_dt_bias = args.in[28]; const float* gdn_norm_w = args.in[29]; const float* gdn_w_out = args.in[30];
    float* MOD = (float*)(ws + WS_MOD); float* RSTD = (float*)(ws + WS_RSTD); float* GB = (float*)(ws + WS_GB);
    bf16* WUP = (bf16*)(ws + WS_WUP); bf16* WIN = (bf16*)(ws + WS_WIN); bf16* WOUT = (bf16*)(ws + WS_WOUT);
    bf16* XMIX = (bf16*)(ws + WS_A); bf16* LWIC = (bf16*)(ws + WS_A); bf16* QKVZ = (bf16*)(ws + WS_A);
    bf16* RKVZ = (bf16*)(ws + WS_B); bf16* QKVc = (bf16*)(ws + WS_B); bf16* G2 = (bf16*)(ws + WS_B);
    float* YF = (float*)(ws + WS_C); float* YB = YF + (size_t)M * D;
    bf16* X1h = (bf16*)(ws + WS_A + 384 * MiB); bf16* X2h = (bf16*)(ws + WS_A + 480 * MiB);
    bf16* GOUT1 = (bf16*)(ws + WS_C + 224 * MiB);
    bf16* YFh = (bf16*)(ws + WS_C); bf16* YBh = YFh + (size_t)M * D;
    float* Y = out + O_Y; float* RS = out + O_RS; float* GS = out + O_GS;
    unsigned char* gsb = (unsigned char*)GS;
    bf16* Gb = (bf16*)(gsb + GS_G); bf16* MID = (bf16*)(gsb + GS_MID); float* AB = (float*)(ws + WS_C + 192 * MiB);

    for (int u = tid; u < (LDS_BYTES - LDSCTL_OFF) / 4; u += NWAVES * 64) ((LAS unsigned*)(lds + LDSCTL_OFF))[u] = 0u;
    __syncthreads();
    const int lo = args.ph_lo, hi = args.ph_hi;
    XcdBarrier bar; bar.bar = (unsigned*)(ctl + CW_BAR); bar.x = 0; bar.st = nullptr;
    if (hi - lo > 1) bar = xcd_barrier_post((unsigned*)(ctl + CW_BAR), MISC + 8);
#ifndef PHMASK
#define PHMASK 0xffffffffu
#endif
#define IN(k) (((PHMASK >> (k)) & 1u) && lo <= (k) && (k) < hi)
#ifndef DUPMASK
#define DUPMASK 0u
#endif
#define PH(k) if (IN(k)) for (int rep_ = 0; rep_ < ((((DUPMASK) >> (k)) & 1u) ? 2 : 1); ++rep_)
#define SEAM(k) do { if (IN(k) && IN((k) + 1)) xcd_barrier(bar); } while (0)

    PH(0) {
        p0_mod(lds, c_in, c_ctx, ada_w, ada_b, MOD, tid, lane, wave, G);
        LAS float* scr = (LAS float*)(lds + wave * 16384);
        constexpr int I_DD = 64 * 128, I_DN = 64 * 4, I_ND = 2 * 128;
        constexpr int NITEMS = 4 * I_DD + 4 * I_DN + 4 * I_ND + I_DD;
        for (int it = gw; it < NITEMS; it += NGW) {
            int r = it;
            if (r < 4 * I_DD) { const int p = r / I_DD; p0_transpose_item(rwkv_w_in + (size_t)p * D * D, D, D, WIN, p * D, scr, r % I_DD, lane); continue; } r -= 4 * I_DD;
            if (r < 2 * I_DN) { const int z = r / I_DN; p0_transpose_item(rwkv_w1 + (size_t)z * D * 128, D, 128, WIN, 16384 + z * 128, scr, r % I_DN, lane); continue; } r -= 2 * I_DN;
            if (r < 2 * I_DN) { const int z = r / I_DN; p0_transpose_item(rwkv_a1 + (size_t)z * D * 128, D, 128, WIN, 16640 + z * 128, scr, r % I_DN, lane); continue; } r -= 2 * I_DN;
            if (r < 2 * I_ND) { const int z = r / I_ND; p0_transpose_item(rwkv_w2 + (size_t)z * 128 * D, 128, D, WUP, z * D, scr, r % I_ND, lane); continue; } r -= 2 * I_ND;
            if (r < 2 * I_ND) { const int z = r / I_ND; p0_transpose_item(rwkv_a2 + (size_t)z * 128 * D, 128, D, WUP, (2 + z) * D, scr, r % I_ND, lane); continue; } r -= 2 * I_ND;
            p0_transpose_item(rwkv_w_out, D, D, WOUT, 0, scr, r, lane);
        }
        __syncthreads();
        norm8_block<0>(lds, x_prompt, x_sample, RSTD, nullptr, nullptr, nullptr, nullptr, bx, G, wave, lane);
    }
    SEAM(0);
    PH(1) p1_mix(x_prompt, x_sample, RSTD, MOD, norm_w, rwkv_mu, XMIX, gw, NGW, lane);
    SEAM(1);
    PH(2) {
        pg8::Gemm g{XMIX, WIN, 6 * M, 16896, D};
        MultiOrder S{G, bx, 4, 16, NPAN, 16, 2, 4 * NPAN, 64, 64, 1};
        EpiP2 E{RKVZ, MID};
        pg8::gemm_phase<EpiP2, MultiOrder, true, true>(lds, g, S, E);
    }
    SEAM(2);
    PH(3) {
        int k3 = 128; asm volatile("" : "+s"(k3));
        pg8::Gemm g{MID, WUP, 4 * M, 4 * D, k3};
        MultiOrder S{G, bx, 4, 16, NPAN, 16, 0, 0, 0, k3 / 64, 1};
        EpiP3 E{LWIC, rwkv_w0, rwkv_a0};
        pg8::gemm_phase<EpiP3, MultiOrder, true, true>(lds, g, S, E);
    }
    SEAM(3);
    PH(4) {
#if defined(RWKV_SEQ)
        LAS float* wl = (LAS float*)(lds + wave * 12288);
        if (wave < 2) {
            for (int lt = bx * 2 + wave; lt < 512; lt += 2 * G) { const int bl = lt >> 7, rem = lt & 127, h = rem >> 1, d = rem & 1;
                rwkv_seq(wl, lane, MC + bl * 1024, 1024, h, d, RKVZ, LWIC, rwkv_k_k, rwkv_k_a, state_rwkv + ((size_t)(bl * 2 + d) * 64 + h) * 4096, nullptr, d ? YB : YF); }
        } else {
            for (int ct = bx * 6 + wave - 2; ct < 4096; ct += 6 * G) { const int b = ct >> 7, rem = ct & 127, h = rem >> 1, d = rem & 1;
                rwkv_seq(wl, lane, b * 256, 256, h, d, RKVZ, LWIC, rwkv_k_k, rwkv_k_a, nullptr, RS + ((size_t)(b * 2 + d) * 64 + h) * 4096, d ? YB : YF); }
        }
#else
        rwkv_chunk_phase(lds, tid, lane, wave, bx, G, RKVZ, LWIC, rwkv_k_k, rwkv_k_a, state_rwkv, RS, YFh, YBh, gdn_w_in, gdn_w_ab, gdn_w_out, WIN, GOUT1);
#endif
    }
    SEAM(4);
    PH(5) p5_post(YFh, YBh, RKVZ, LWIC, rwkv_ln_w, rwkv_ln_b, rwkv_k_a, rwkv_r_k, Gb, gw, NGW, lane);
    SEAM(5);
    PH(6) {
        pg8::Gemm g{Gb, WOUT, M, D, D};
        MultiOrder S{G, bx, 1, 16, 0, 0, 0, 0, 0, 64, 1};
        EpiRes<false, true> E{x_prompt, x_sample, X1h, MOD};
        pg8::gemm_phase<EpiRes<false, true>, MultiOrder, true, true>(lds, g, S, E);
    }
    SEAM(6);
    PH(7) {
        norm8_block<1, true>(lds, (const float*)X1h, nullptr, nullptr, MOD + 5 * 12288, norm_w + D, Gb, nullptr, bx, G, wave, lane);
    }
    SEAM(7);
    PH(8) {
        pg8::Gemm g{Gb, WIN, M, 16640, D};
        MultiOrder S{G, bx, 1, 64, 0, 0, 1, 0, 64, 64, 4};
        EpiP8 E{QKVZ, AB};
        pg8::gemm_phase<EpiP8, MultiOrder, true, true>(lds, g, S, E);
    }
    SEAM(8);
    PH(9) p9_prep(QKVZ, AB, gdn_conv, gdn_A_log, gdn_dt_bias, QKVc, GB, gw, NGW, lane);
    SEAM(9);
    PH(10) {
#if defined(GDN_SEQ)
        LAS float* wl = (LAS float*)(lds + wave * 12288);
        float* OFb = YF; float* OBb = YB;
        if (wave < 2) {
            for (int lt = bx * 2 + wave; lt < 512; lt += 2 * G) { const int bl = lt >> 7, rem = lt & 127, h = rem >> 2, d = (rem >> 1) & 1, hv = rem & 1;
                gdn_seq(wl, lane, MC + bl * 1024, 1024, h, d, hv, QKVc, GB, state_gdn + ((size_t)(bl * 2 + d) * 32 + h) * 16384, nullptr, d ? OBb : OFb); }
        } else {
            for (int ct = bx * 6 + wave - 2; ct < 4096; ct += 6 * G) { const int b = ct >> 7, rem = ct & 127, h = rem >> 2, d = (rem >> 1) & 1, hv = rem & 1;
                gdn_seq(wl, lane, b * 256, 256, h, d, hv, QKVc, GB, nullptr, GS + ((size_t)(b * 2 + d) * 32 + h) * 16384, d ? OBb : OFb); }
        }
#else
        gdn_chunk_phase(lds, tid, lane, wave, bx, G, QKVc, GB, state_gdn, GS, YFh, YBh);
#endif
    }
    SEAM(10);
    PH(11) p11_post(YFh, YBh, QKVZ, gdn_norm_w, G2, gw, NGW, lane);
    SEAM(11);
    PH(12) {
        pg8::Gemm g{G2, GOUT1, M, D, D};
        MultiOrder S{G, bx, 1, 16, 0, 0, 0, 0, 0, 64, 1};
        EpiRes<true, true> E{X1h, X1h + (size_t)MC * D, X2h, MOD + 5 * 12288};
        pg8::gemm_phase<EpiRes<true, true>, MultiOrder, true, true>(lds, g, S, E);
    }
    SEAM(12);
    PH(13) norm8_block<2, true>(lds, (const float*)X2h, nullptr, nullptr, nullptr, final_norm_w, nullptr, Y, bx, G, wave, lane);
#undef IN
#undef SEAM
}

extern "C" void kernel_launch(void* const* d_in, const int* in_sizes, int n_in, void* d_out, int out_size, void* d_ws, size_t ws_size, hipStream_t stream) {
    static int grid = 0;
    if (grid == 0) {
        if (n_in != 31 || (size_t)out_size != O_END || ws_size < WS_END) { fprintf(stderr, "kernel_launch: unexpected shapes: n_in %d out %d ws %zu\n", n_in, out_size, ws_size); grid = -1; return; }
        int dev = 0, cus = 0, per_cu = 0;
        if (hipGetDevice(&dev) != hipSuccess || hipDeviceGetAttribute(&cus, hipDeviceAttributeMultiprocessorCount, dev) != hipSuccess) { grid = -1; return; }
        if (hipFuncSetAttribute((const void*)mk_fwd, hipFuncAttributeMaxDynamicSharedMemorySize, LDS_BYTES) != hipSuccess) { fprintf(stderr, "kernel_launch: hipFuncSetAttribute failed\n"); grid = -1; return; }
        if (hipOccupancyMaxActiveBlocksPerMultiprocessor(&per_cu, (const void*)mk_fwd, NWAVES * 64, LDS_BYTES) != hipSuccess || per_cu < 1) fprintf(stderr, "kernel_launch: occupancy query says %d\n", per_cu);
        (void)hipGetLastError();
        grid = cus;
    }
    if (grid < 0) return;
    if (hipMemsetAsync((char*)d_ws + WS_CTL, 0, CTL_ZERO_BYTES, stream) != hipSuccess) return;
    Args a{};
    for (int i = 0; i < 31; ++i) a.in[i] = (const float*)d_in[i];
    a.out = (float*)d_out; a.ws = (unsigned char*)d_ws;
#if MK_ONE_LAUNCH
    a.ph_lo = 0; a.ph_hi = NPH;
    hipLaunchKernelGGL(mk_fwd, dim3(grid), dim3(NWAVES * 64), LDS_BYTES, stream, a);
#else
    for (int p = 0; p < NPH; ++p) { a.ph_lo = p; a.ph_hi = p + 1; hipLaunchKernelGGL(mk_fwd, dim3(grid), dim3(NWAVES * 64), LDS_BYTES, stream, a); }
#endif
}
```

```cpp
#include <hip/hip_runtime.h>
#include <cstdio>
#include <cstdint>
namespace pg8 {
#define PG8_LAS __attribute__((address_space(3)))
typedef unsigned short bf16_t;
typedef short bf16x8 __attribute__((ext_vector_type(8)));
typedef float f32x4 __attribute__((ext_vector_type(4)));
typedef unsigned u32x4 __attribute__((ext_vector_type(4)));
constexpr int BM = 256, BK = 64, HALF = 128, HTB = HALF * BK * 2  , STAGE_BYTES = 8 * HTB, NXCD = 8, WGM = 8;

__host__ __device__ __forceinline__ int lds_byte(int r, int c) { const int st = (r >> 4) * 2 + (c >> 5), rr = r & 15, cc = c & 31, ob = rr * 64 + cc * 2; return st * 1024 + (ob ^ (((ob >> 9) & 1) << 5)); }
__host__ __device__ __forceinline__ void stage_rc(int b, int& R, int& C) { const int st = b / 1024, sb = b % 1024, swz = sb ^ (((sb >> 9) & 1) << 5); R = (st >> 1) * 16 + swz / 64; C = (st & 1) * 32 + (swz % 64) / 2; }
__host__ __device__ __forceinline__ int perm32(int rho) { const int n = rho >> 4, i = rho & 15; return 8 * (i >> 2) + 4 * n + (i & 3); }

struct Unit { int pm, pn, k0, nt; };
struct Gemm { const bf16_t* A; const bf16_t* Bt; int M, N, K; };

__device__ __forceinline__ unsigned cvt_pk_bf16(float lo, float hi) { unsigned r; asm volatile("v_cvt_pk_bf16_f32 %0, %1, %2" : "=v"(r) : "v"(lo), "v"(hi)); return r; }

template <class Epi, class Sched, bool ALIGN_EPI = false, bool SP2 = false>
__device__ __forceinline__ void gemm_phase(PG8_LAS unsigned char* lds, const Gemm g, const Sched& S, const Epi& E) {
    const int tid = threadIdx.x, wid = __builtin_amdgcn_readfirstlane(tid >> 6), lane = tid & 63, wr = wid >> 2, wc = wid & 3, fr = lane & 15, fq = lane >> 4;
    const int K = g.K;
    unsigned voffA[2], voffB[2];
#pragma unroll
    for (int i = 0; i < 2; ++i) { int R, C; stage_rc(tid * 16 + i * 8192, R, C); const int Rb = Epi::PERM ? ((R & ~31) + perm32(R & 31)) : R;
        voffA[i] = (unsigned)(R * K + C) * 2u; voffB[i] = (unsigned)(Rb * K + C) * 2u; }
    const size_t kstep = (size_t)(BK * 2);
    const size_t hstep = (size_t)HALF * K * 2;
    const size_t tstep = 2 * hstep;
    const unsigned ldsw = (unsigned)wid * 1024u;
    const int aoff = lds_byte(wr * 64 + fr, fq * 8), boff = lds_byte(wc * 32 + fr, fq * 8);
#define PG8_SA(b, h) (((b) * 2 + (h)) * HTB)
#define PG8_SB(b, h) ((4 + (b) * 2 + (h)) * HTB)
#define PG8_STAGE(bufoff, gbase, voff) do { _Pragma("unroll") for (int _i = 0; _i < 2; ++_i) \
        __builtin_amdgcn_global_load_lds((const unsigned*)((const char*)(gbase) + (voff)[_i]), (PG8_LAS unsigned*)(lds + (bufoff) + ldsw + _i * 8192), 16, 0, 0); } while (0)
#define PG8_LDA(dst, b, h) do { _Pragma("unroll") for (int m = 0; m < 4; ++m) _Pragma("unroll") for (int k = 0; k < 2; ++k) dst[m][k] = *(const PG8_LAS bf16x8*)(lds + PG8_SA(b, h) + aoff + m * 2048 + k * 1024); } while (0)
#define PG8_LDB(dst, b, h) do { _Pragma("unroll") for (int n = 0; n < 2; ++n) _Pragma("unroll") for (int k = 0; k < 2; ++k) dst[n][k] = *(const PG8_LAS bf16x8*)(lds + PG8_SB(b, h) + boff + n * 2048 + k * 1024); } while (0)
#define PG8_MMA(ai, bj, At, Bt) do { __builtin_amdgcn_s_setprio(1); _Pragma("unroll") for (int m = 0; m < 4; ++m) _Pragma("unroll") for (int n = 0; n < 2; ++n) _Pragma("unroll") for (int k = 0; k < 2; ++k) \
        acc[ai][bj][m][n] = __builtin_amdgcn_mfma_f32_16x16x32_bf16(Bt[n][k], At[m][k], acc[ai][bj][m][n], 0, 0, 0); __builtin_amdgcn_s_setprio(0); } while (0)
#define PG8_WAIT_V(n) asm volatile("s_waitcnt vmcnt(" #n ")" ::: "memory")
#define PG8_WAIT_L(n) asm volatile("s_waitcnt lgkmcnt(" #n ")" ::: "memory")
#define PG8_BAR __builtin_amdgcn_s_barrier()
#define PG8_SCHED __builtin_amdgcn_sched_barrier(0)
    Unit cur, nxt; int ui = 0;
    if (!S.next(0, cur)) return;
    f32x4 acc[2][2][4][2];
#pragma unroll
    for (int a = 0; a < 2; ++a)
#pragma unroll
        for (int b = 0; b < 2; ++b)
#pragma unroll
            for (int m = 0; m < 4; ++m)
#pragma unroll
                for (int n = 0; n < 2; ++n) acc[a][b][m][n] = (f32x4){0.f, 0.f, 0.f, 0.f};
    bf16x8 At[4][2], B0[2][2], B1[2][2];
    const char* cA = (const char*)g.A + (size_t)cur.pm * tstep + (size_t)cur.k0 * 2; const char* cB = (const char*)g.Bt + (size_t)cur.pn * tstep + (size_t)cur.k0 * 2;
    S.a_ready(cur);
    if constexpr (SP2) {
        PG8_STAGE(PG8_SB(0, 0), cB, voffB); PG8_STAGE(PG8_SB(0, 1), cB + hstep, voffB); PG8_STAGE(PG8_SA(0, 0), cA, voffA); PG8_STAGE(PG8_SA(0, 1), cA + hstep, voffA);
        if (wr == 1) PG8_BAR;
        PG8_WAIT_V(2); PG8_BAR;
        PG8_STAGE(PG8_SB(1, 0), cB + kstep, voffB); PG8_STAGE(PG8_SA(1, 0), cA + kstep, voffA); PG8_STAGE(PG8_SB(1, 1), cB + hstep + kstep, voffB);
        PG8_WAIT_V(6); PG8_BAR;
    } else {
        PG8_STAGE(PG8_SB(0, 0), cB, voffB); PG8_STAGE(PG8_SA(0, 0), cA, voffA); PG8_STAGE(PG8_SB(0, 1), cB + hstep, voffB); PG8_STAGE(PG8_SA(0, 1), cA + hstep, voffA);
        if (wr == 1) PG8_BAR;
        PG8_WAIT_V(4); PG8_BAR;
        PG8_STAGE(PG8_SB(1, 0), cB + kstep, voffB); PG8_STAGE(PG8_SA(1, 0), cA + kstep, voffA); PG8_STAGE(PG8_SB(1, 1), cB + hstep + kstep, voffB);
        PG8_WAIT_V(6); PG8_BAR;
    }
    for (;;) {
        const bool has_next = S.next(ui + 1, nxt);
        const char* nA = has_next ? (const char*)g.A + (size_t)nxt.pm * tstep + (size_t)nxt.k0 * 2 : cA; const char* nB = has_next ? (const char*)g.Bt + (size_t)nxt.pn * tstep + (size_t)nxt.k0 * 2 : cB;
        const int nt = cur.nt;
        for (int t = 0; t < nt; t += 2) {
            const bool last = (t == nt - 2);
            const char* a1 = cA + (size_t)(t + 1) * kstep;
            const char* a2 = last ? nA : cA + (size_t)(t + 2) * kstep; const char* b2 = last ? nB : cB + (size_t)(t + 2) * kstep;
            const char* a3 = a2 + kstep; const char* b3 = b2 + kstep;
            if (last && has_next) S.a_ready(nxt);
            if constexpr (SP2) {
            PG8_LDB(B0, 0, 0); PG8_LDB(B1, 0, 1); PG8_SCHED; PG8_LDA(At, 0, 0); PG8_STAGE(PG8_SA(1, 1), a1 + hstep, voffA);
            PG8_WAIT_V(8); PG8_WAIT_L(0); PG8_BAR; PG8_MMA(0, 0, At, B0); PG8_MMA(0, 1, At, B1); PG8_BAR; PG8_SCHED;
            PG8_LDA(At, 0, 1); PG8_STAGE(PG8_SB(0, 0), b2, voffB); PG8_STAGE(PG8_SB(0, 1), b2 + hstep, voffB); PG8_STAGE(PG8_SA(0, 0), a2, voffA);
            PG8_WAIT_V(8); PG8_WAIT_L(0); PG8_BAR; PG8_MMA(1, 0, At, B0); PG8_MMA(1, 1, At, B1); PG8_BAR; PG8_SCHED;
            PG8_LDB(B0, 1, 0); PG8_LDB(B1, 1, 1); PG8_SCHED; PG8_LDA(At, 1, 0); PG8_STAGE(PG8_SA(0, 1), a2 + hstep, voffA);
            PG8_WAIT_V(8); PG8_WAIT_L(0); PG8_BAR; PG8_MMA(0, 0, At, B0); PG8_MMA(0, 1, At, B1); PG8_BAR; PG8_SCHED;
            PG8_LDA(At, 1, 1); PG8_STAGE(PG8_SB(1, 0), b3, voffB); PG8_STAGE(PG8_SB(1, 1), b3 + hstep, voffB); PG8_STAGE(PG8_SA(1, 0), a3, voffA);
            PG8_WAIT_V(8); PG8_WAIT_L(0); PG8_BAR; PG8_MMA(1, 0, At, B0); PG8_MMA(1, 1, At, B1); PG8_BAR; PG8_SCHED;
            } else {
            PG8_LDB(B0, 0, 0); PG8_SCHED; PG8_LDA(At, 0, 0); PG8_STAGE(PG8_SA(1, 1), a1 + hstep, voffA);
            PG8_WAIT_L(8); PG8_BAR; PG8_WAIT_L(0); PG8_MMA(0, 0, At, B0); PG8_BAR; PG8_SCHED;
            PG8_LDB(B1, 0, 1); PG8_STAGE(PG8_SB(0, 0), b2, voffB);
            PG8_BAR; PG8_WAIT_L(0); PG8_MMA(0, 1, At, B1); PG8_BAR;
            PG8_LDA(At, 0, 1); PG8_STAGE(PG8_SA(0, 0), a2, voffA);
            PG8_BAR; PG8_WAIT_L(0); PG8_MMA(1, 0, At, B0); PG8_BAR; PG8_SCHED;
            PG8_STAGE(PG8_SB(0, 1), b2 + hstep, voffB);
            PG8_WAIT_V(6); PG8_BAR; PG8_MMA(1, 1, At, B1); PG8_BAR;
            PG8_LDB(B0, 1, 0); PG8_SCHED; PG8_LDA(At, 1, 0); PG8_STAGE(PG8_SA(0, 1), a2 + hstep, voffA);
            PG8_WAIT_L(8); PG8_BAR; PG8_WAIT_L(0); PG8_MMA(0, 0, At, B0); PG8_BAR; PG8_SCHED;
            PG8_LDB(B1, 1, 1); PG8_STAGE(PG8_SB(1, 0), b3, voffB);
            PG8_BAR; PG8_WAIT_L(0); PG8_MMA(0, 1, At, B1); PG8_BAR;
            PG8_LDA(At, 1, 1); PG8_STAGE(PG8_SA(1, 0), a3, voffA);
            PG8_BAR; PG8_WAIT_L(0); PG8_MMA(1, 0, At, B0); PG8_BAR; PG8_SCHED;
            PG8_STAGE(PG8_SB(1, 1), b3 + hstep, voffB);
            PG8_WAIT_V(6); PG8_BAR; PG8_MMA(1, 1, At, B1); PG8_BAR;
            }
        }
        if constexpr (ALIGN_EPI) { if (wr == 0) PG8_BAR; }
        if constexpr (!Epi::AFTER_DRAIN) { E(acc, cur, wr, wc, fr, fq); S.done(cur); }
        if (!has_next) break;
#pragma unroll
        for (int a = 0; a < 2; ++a)
#pragma unroll
            for (int b = 0; b < 2; ++b)
#pragma unroll
                for (int m = 0; m < 4; ++m)
#pragma unroll
                    for (int n = 0; n < 2; ++n) acc[a][b][m][n] = (f32x4){0.f, 0.f, 0.f, 0.f};
        cur = nxt; cA = nA; cB = nB; ++ui;
        if constexpr (ALIGN_EPI) { if (wr == 1) PG8_BAR; }
    }
    PG8_WAIT_V(0);
    if constexpr (!ALIGN_EPI) { if (wr == 0) PG8_BAR; }
    PG8_BAR;
    if constexpr (Epi::AFTER_DRAIN) { E.fused(acc, cur, wr, wc, fr, fq, lds, wid, lane); S.done(cur); }
#undef PG8_SA
#undef PG8_SB
#undef PG8_STAGE
#undef PG8_LDA
#undef PG8_LDB
#undef PG8_MMA
#undef PG8_WAIT_V
#undef PG8_WAIT_L
#undef PG8_BAR
#undef PG8_SCHED
}
}

#ifndef MK_ONE_LAUNCH
#define MK_ONE_LAUNCH 1
#endif
constexpr int NWAVES = 8;
constexpr int D = 4096, MC = 8192, MLAT = 4096, M = MC + MLAT, NPAN = M / 256;
constexpr int NPH = 14;
constexpr size_t MiB = 1u << 20;
constexpr size_t WS_CTL = 0, CTL_ZERO_BYTES = 64 * 1024;
constexpr size_t WS_MOD = 1 * MiB;
constexpr size_t WS_RSTD = 2 * MiB;
constexpr size_t WS_GB = 3 * MiB;
constexpr size_t WS_WUP = 10 * MiB;
constexpr size_t WS_WIN = 16 * MiB;
constexpr size_t WS_WOUT = 148 * MiB;
constexpr size_t WS_A = 180 * MiB;
constexpr size_t WS_B = 756 * MiB;
constexpr size_t WS_C = 1140 * MiB;
constexpr size_t WS_END = 1524 * MiB;
constexpr size_t O_Y = 0, O_RS = (size_t)M * D, O_GS = O_RS + (size_t)32 * 2 * 64 * 64 * 64, O_END = O_GS + (size_t)32 * 2 * 32 * 128 * 128;
constexpr size_t GS_G = 0;
constexpr size_t GS_MID = 96 * MiB;
constexpr size_t GS_AB = 108 * MiB;
constexpr int CW_BAR = 4096;

constexpr int RING_BYTES = 143360, LDSCTL_OFF = RING_BYTES, MISC_OFF = LDSCTL_OFF + 320, LDS_BYTES = 147456;

#define GAS __attribute__((address_space(1)))
#define LAS __attribute__((address_space(3)))
typedef unsigned short bf16;
typedef unsigned v4u __attribute__((ext_vector_type(4)));
typedef unsigned v2u __attribute__((ext_vector_type(2)));
typedef float f32x4 __attribute__((ext_vector_type(4)));
typedef GAS unsigned gu32;
#define RLX_AGENT __ATOMIC_RELAXED, __HIP_MEMORY_SCOPE_AGENT
#define LDS_WAIT() asm volatile("s_waitcnt lgkmcnt(0)" ::: "memory")
#define VM_WAIT() asm volatile("s_waitcnt vmcnt(0)" ::: "memory")
__device__ __forceinline__ unsigned f2bf(float f) { unsigned u = __builtin_bit_cast(unsigned, f); return (u + 0x7fffu + ((u >> 16) & 1u)) >> 16; }
typedef float f32x2_t __attribute__((ext_vector_type(2))); typedef __bf16 bf16x2_t __attribute__((ext_vector_type(2)));
__device__ __forceinline__ unsigned cvtpk(float lo, float hi) { f32x2_t v = {lo, hi}; bf16x2_t b = __builtin_convertvector(v, bf16x2_t); return __builtin_bit_cast(unsigned, b); }
__device__ __forceinline__ unsigned pk2(float lo, float hi) { return cvtpk(lo, hi); }
__device__ __forceinline__ float bf2f(unsigned short b) { return __builtin_bit_cast(float, (unsigned)b << 16); }
__device__ __forceinline__ f32x4 bf4(v2u w) { f32x4 r; r.x = __builtin_bit_cast(float, w.x << 16); r.y = __builtin_bit_cast(float, w.x & 0xffff0000u); r.z = __builtin_bit_cast(float, w.y << 16); r.w = __builtin_bit_cast(float, w.y & 0xffff0000u); return r; }
__device__ __forceinline__ v2u pk4(f32x4 v) { v2u r; r.x = pk2(v.x, v.y); r.y = pk2(v.z, v.w); return r; }
__device__ __forceinline__ float sigmoidf_(float x) { return __builtin_amdgcn_rcpf(1.f + __expf(-x)); }
__device__ __forceinline__ float siluf_(float x) { return x * __builtin_amdgcn_rcpf(1.f + __expf(-x)); }
__device__ __forceinline__ float softplusf_(float x) { return fmaxf(x, 0.f) + log1pf(__expf(-fabsf(x))); }
__device__ __forceinline__ f32x4 silu4(f32x4 v) { f32x4 r; r.x = siluf_(v.x); r.y = siluf_(v.y); r.z = siluf_(v.z); r.w = siluf_(v.w); return r; }
#define XB_TMO      128
#define XB_XCNT(j)  (256  + 64 * (j))
#define XB_XSUB(j)  (1280 + 64 * (j))
#define XB_XGEN(j)  (2304 + 64 * (j))
#define XB_TOP      3328
#define XB_TOPGEN   3392
#define XCD_BAR_WORDS 3456
#define XB_SPIN_CAP (1u << 18)

__device__ __forceinline__ unsigned xb_ld(unsigned* p)              { return __hip_atomic_load(p, __ATOMIC_RELAXED, __HIP_MEMORY_SCOPE_AGENT); }
__device__ __forceinline__ unsigned xb_add(unsigned* p, unsigned v) { return __hip_atomic_fetch_add(p, v, __ATOMIC_RELAXED, __HIP_MEMORY_SCOPE_AGENT); }
__device__ __forceinline__ unsigned xb_xcc_id() { return (unsigned)__builtin_amdgcn_s_getreg((3 << 11) | 20) & 0xFu; }
#define XB_SPIN(cond, bar) do { unsigned _sp = 0; while (cond) { __builtin_amdgcn_s_sleep(1); \
    if ((++_sp & 255u) == 0u) { if (xb_ld(&(bar)[XB_TMO])) break; if (_sp > XB_SPIN_CAP) { atomicAdd(&(bar)[XB_TMO], 1u); break; } } } } while (0)

struct XcdBarrier {
    unsigned* bar; unsigned x;
    volatile LAS unsigned* st;
};

__device__ __forceinline__ XcdBarrier xcd_barrier_post(unsigned* bar, volatile LAS unsigned* st) {
    XcdBarrier b; b.bar = bar; b.x = xb_xcc_id(); b.st = st;
    if (threadIdx.x == 0) (void)xb_add(&bar[XB_XCNT(b.x)], 1u);
    return b;
}
__device__ __forceinline__ void xcd_barrier_complete(unsigned* bar, unsigned x, unsigned& nloc, unsigned& nx) {
    const unsigned G = gridDim.x * gridDim.y * gridDim.z;
    unsigned sum, cnt, mine, sp = 0u;
    for (;;) {
        sum = 0u; cnt = 0u; mine = 0u;
#pragma unroll
        for (unsigned j = 0; j < 16; ++j) { const unsigned c = xb_ld(&bar[XB_XCNT(j)]); sum += c; cnt += (c > 0u) ? 1u : 0u; mine = (j == x) ? c : mine; }
        if (sum == G) break;
        __builtin_amdgcn_s_sleep(1);
        if ((++sp & 255u) == 0u) { if (xb_ld(&bar[XB_TMO])) break; if (sp > XB_SPIN_CAP) { atomicAdd(&bar[XB_TMO], 1u); break; } }
    }
    nloc = mine > 0u ? mine : 1u; nx = cnt > 0u ? cnt : 1u;
}

__device__ __forceinline__ void xcd_barrier(const XcdBarrier& b) {
    asm volatile("s_waitcnt vmcnt(0)" ::: "memory");
    __syncthreads();
    if (threadIdx.x == 0) {
        unsigned* bar = b.bar;
        __builtin_amdgcn_s_waitcnt(0);
        unsigned nloc = b.st[0], nx = b.st[1];
        if (nloc == 0u) { xcd_barrier_complete(bar, b.x, nloc, nx); b.st[0] = nloc; b.st[1] = nx; }
        const unsigned old = xb_add(&bar[XB_XSUB(b.x)], 1u);
        const unsigned gen = old / nloc;
        if (old + 1u == (gen + 1u) * nloc) {
            __builtin_amdgcn_fence(__ATOMIC_RELEASE, "agent");
            asm volatile("s_waitcnt vmcnt(0)" ::: "memory");
            const unsigned og = xb_add(&bar[XB_TOP], 1u);
            const unsigned tg = og / nx;
            if (og + 1u == (tg + 1u) * nx) xb_add(&bar[XB_TOPGEN], 1u);
            else XB_SPIN(xb_ld(&bar[XB_TOPGEN]) == tg, bar);
            __builtin_amdgcn_fence(__ATOMIC_ACQUIRE, "agent");
            xb_add(&bar[XB_XGEN(b.x)], 1u);
            asm volatile("s_waitcnt vmcnt(0)" ::: "memory");
        } else {
            XB_SPIN(xb_ld(&bar[XB_XGEN(b.x)]) == gen, bar);
            __builtin_amdgcn_fence(__ATOMIC_ACQUIRE, "agent");
            asm volatile("s_waitcnt vmcnt(0)" ::: "memory");
        }
    }
    __syncthreads();
}
__device__ __forceinline__ float wave_sum(float v) {
#pragma unroll
    for (int o = 1; o < 64; o <<= 1) v += __shfl_xor(v, o);
    return v;
}
__device__ __forceinline__ void p0_transpose_item(const float* W, int K, int N, bf16* WT, int row_off, LAS float* scr, int item, int lane) {
    const int nblk = N / 32, kb = item / nblk, nb = item % nblk, k0 = 64 * kb, n0 = 32 * nb;
#pragma unroll
    for (int i = 0; i < 8; ++i) { const int kk = 8 * i + (lane >> 3); const f32x4 w = __builtin_nontemporal_load((const f32x4*)(W + (size_t)(k0 + kk) * N + n0 + 4 * (lane & 7)));
        LAS float* d = scr + kk * 33 + 4 * (lane & 7); d[0] = w.x; d[1] = w.y; d[2] = w.z; d[3] = w.w; }
    LDS_WAIT(); asm volatile("" ::: "memory");
    const int c = lane & 7;
#pragma unroll
    for (int j = 0; j < 4; ++j) { const int n = (lane >> 3) + 8 * j; const LAS float* s = scr + (8 * c) * 33 + n;
        v4u o; o.x = pk2(s[0 * 33], s[1 * 33]); o.y = pk2(s[2 * 33], s[3 * 33]); o.z = pk2(s[4 * 33], s[5 * 33]); o.w = pk2(s[6 * 33], s[7 * 33]);
        *(GAS v4u*)(WT + (size_t)(row_off + n0 + n) * K + k0 + 8 * c) = o; }
    LDS_WAIT(); asm volatile("" ::: "memory");
}

typedef short bf16x8 __attribute__((ext_vector_type(8)));
typedef float f32x16 __attribute__((ext_vector_type(16)));
typedef short s16x4 __attribute__((ext_vector_type(4)));
typedef short v4i16_t __attribute__((ext_vector_type(4)));
#define MFMA32(a, b, c) __builtin_amdgcn_mfma_f32_32x32x16_bf16((a), (b), (c), 0, 0, 0)
#define WG_BAR() do { asm volatile("s_waitcnt vmcnt(0) lgkmcnt(0)" ::: "memory"); __builtin_amdgcn_s_barrier(); asm volatile("" ::: "memory"); } while (0)
#define LDS_BAR() do { asm volatile("s_waitcnt lgkmcnt(0)" ::: "memory"); __builtin_amdgcn_s_barrier(); asm volatile("" ::: "memory"); } while (0)

__device__ __forceinline__ bf16x8 frag_row(LAS unsigned char* img, int P, int row0, int s, int lane) {
    return *(const LAS bf16x8*)(img + (row0 + (lane & 31)) * P + (16 * s + 8 * (lane >> 5)) * 2);
}
__device__ __forceinline__ bf16x8 frag_tr(LAS unsigned char* img, int P, int k0, int n0, int lane) {
    const int h = lane >> 5, blk = (lane >> 4) & 1, q = (lane & 15) >> 2, p = lane & 3;
    LAS unsigned char* a = img + (k0 + 8 * h + q) * P + n0 * 2 + 32 * blk + 8 * p;
    const s16x4 lo = __builtin_bit_cast(s16x4, __builtin_amdgcn_ds_read_tr16_b64_v4i16((LAS v4i16_t*)a));
    const s16x4 hi = __builtin_bit_cast(s16x4, __builtin_amdgcn_ds_read_tr16_b64_v4i16((LAS v4i16_t*)(a + 4 * P)));
    return __builtin_shufflevector(lo, hi, 0, 1, 2, 3, 4, 5, 6, 7);
}
__device__ __forceinline__ float wave_sum_dpp(float v) {
#define DPP_(x, ctrl, rmask) __builtin_bit_cast(float, __builtin_amdgcn_update_dpp(0, __builtin_bit_cast(int, (x)), (ctrl), (rmask), 0xf, false))
    v += DPP_(v, 0xB1, 0xf);
    v += DPP_(v, 0x4E, 0xf);
    v += DPP_(v, 0x141, 0xf);
    v += DPP_(v, 0x140, 0xf);
    v += DPP_(v, 0x142, 0xa);
    v += DPP_(v, 0x143, 0xc);
#undef DPP_
    return __builtin_bit_cast(float, __builtin_amdgcn_readlane(__builtin_bit_cast(int, v), 63));
}
__device__ __forceinline__ float wave_incl_scan_dpp(float v) {
#define DPP_(x, ctrl, rmask) __builtin_bit_cast(float, __builtin_amdgcn_update_dpp(0, __builtin_bit_cast(int, (x)), (ctrl), (rmask), 0xf, false))
    v += DPP_(v, 0x111, 0xf); v += DPP_(v, 0x112, 0xf); v += DPP_(v, 0x114, 0xf); v += DPP_(v, 0x118, 0xf);
    v += DPP_(v, 0x142, 0xa); v += DPP_(v, 0x143, 0xc);
#undef DPP_
    return v;
}
__device__ __forceinline__ int crow(int i, int h) { return (i & 3) + 8 * (i >> 2) + 4 * h; }
__device__ __forceinline__ void store_tile_T(LAS unsigned char* img, int P, int n0, int m0, const f32x16& acc, int lane) {
    LAS unsigned char* p = img + (n0 + (lane & 31)) * P + (m0 + 4 * (lane >> 5)) * 2;
#pragma unroll
    for (int g = 0; g < 4; ++g) { v2u w; w.x = cvtpk(acc[4 * g], acc[4 * g + 1]); w.y = cvtpk(acc[4 * g + 2], acc[4 * g + 3]); *(LAS v2u*)(p + 16 * g) = w; }
}
__device__ __forceinline__ f32x16 zero16() { f32x16 z; for (int i = 0; i < 16; ++i) z[i] = 0.f; return z; }


__device__ __forceinline__ f32x16 ltri_tile(LAS unsigned char* X, LAS unsigned char* Y, int t, int lane) {
    f32x16 acc = zero16();
    const int mb = t ? 32 : 0, nb = (t == 2) ? 32 : 0;
#pragma unroll
    for (int ks = 0; ks < 4; ++ks) { if ((t == 0 && ks >= 2) || (t == 2 && ks < 2)) continue; acc = MFMA32(frag_tr(Y, 144, 16 * ks, nb, lane), frag_row(X, 144, mb, ks, lane), acc); }
    return acc;
}
__device__ __forceinline__ void ltri_store1(LAS unsigned char* img, int t, const f32x16& acc, int lane) { store_tile_T(img, 144, t ? 32 : 0, (t == 2) ? 32 : 0, acc, lane); }
__device__ __forceinline__ void tri_inverse64(LAS unsigned char* LF, LAS unsigned char* LOFF, LAS unsigned char* DD, LAS unsigned char* NI, LAS unsigned char* N2I, LAS unsigned char* SI, int lane) {
    const int b = lane >> 4; const int hh = lane >> 5, l31 = lane & 31;
    {
        unsigned lfa = (unsigned)(size_t)LF + (unsigned)b * (16u * 272u + 64u); asm volatile("" : "+v"(lfa));
        LAS unsigned char* lf = (LAS unsigned char*)(size_t)lfa;
        int c_o = lane & 15; asm volatile("" : "+v"(c_o));
        float Td[16];
#pragma unroll
        for (int i = 0; i < 16; ++i) {
            float a0 = (c_o == i) ? 1.f : 0.f, a1 = 0.f, a2 = 0.f, a3 = 0.f;
#pragma unroll
            for (int j4 = 0; j4 < (i + 3) / 4; ++j4) { const f32x4 l = *(const LAS f32x4*)(lf + i * 272 + j4 * 16);
                if (4 * j4 + 0 < i) a0 -= l.x * Td[4 * j4 + 0]; if (4 * j4 + 1 < i) a1 -= l.y * Td[4 * j4 + 1]; if (4 * j4 + 2 < i) a2 -= l.z * Td[4 * j4 + 2]; if (4 * j4 + 3 < i) a3 -= l.w * Td[4 * j4 + 3]; }
            Td[i] = (a0 + a1) + (a2 + a3);
        }
        asm volatile("" ::: "memory");
        LAS unsigned char* dd = DD + lane * 2;
#pragma unroll
        for (int bb = 0; bb < 4; ++bb)
#pragma unroll
            for (int ii = 0; ii < 16; ++ii) *(LAS bf16*)(dd + (16 * bb + ii) * 144) = (bf16)f2bf(bb == b ? Td[ii] : 0.f);
    }
    asm volatile("" ::: "memory");
    f32x16 sacc[3];
    {
        f32x16 p[3];
#pragma unroll
        for (int t = 0; t < 3; ++t) p[t] = ltri_tile(DD, LOFF, t, lane);
#pragma unroll
        for (int t = 0; t < 3; ++t) { ltri_store1(NI, t, p[t], lane);
#pragma unroll
            for (int r = 0; r < 16; ++r) sacc[t][r] = ((t != 1 && l31 == crow(r, hh)) ? 1.f : 0.f) - p[t][r]; }
    }
    asm volatile("" ::: "memory");
    {
        f32x16 p[3];
#pragma unroll
        for (int t = 0; t < 3; ++t) p[t] = ltri_tile(NI, NI, t, lane);
#pragma unroll
        for (int t = 0; t < 3; ++t) { ltri_store1(N2I, t, p[t], lane);
#pragma unroll
            for (int r = 0; r < 16; ++r) sacc[t][r] += p[t][r]; }
    }
    asm volatile("" ::: "memory");
    {
        f32x16 p[3];
#pragma unroll
        for (int t = 0; t < 3; ++t) p[t] = ltri_tile(NI, N2I, t, lane);
#pragma unroll
        for (int t = 0; t < 3; ++t)
#pragma unroll
            for (int r = 0; r < 16; ++r) sacc[t][r] -= p[t][r];
    }
    asm volatile("" ::: "memory");
#pragma unroll
    for (int t = 0; t < 3; ++t) ltri_store1(SI, t, sacc[t], lane);
    asm volatile("" ::: "memory");
}


__device__ __forceinline__ void inv_stepA(LAS unsigned char* LF, LAS unsigned char* DD, int lane) {
    const int b = lane >> 4;
    unsigned lfa = (unsigned)(size_t)LF + (unsigned)b * (16u * 272u + 64u); asm volatile("" : "+v"(lfa));
    LAS unsigned char* lf = (LAS unsigned char*)(size_t)lfa;
    int c_o = lane & 15; asm volatile("" : "+v"(c_o));
    typedef float f32x2v __attribute__((ext_vector_type(2)));
    f32x2v T2[8];
#pragma unroll
    for (int k = 0; k < 8; ++k) T2[k] = (f32x2v){0.f, 0.f};
#pragma unroll
    for (int i = 0; i < 16; ++i) {
        f32x2v a = (f32x2v){(c_o == i) ? 1.f : 0.f, 0.f}, a2 = (f32x2v){0.f, 0.f};
#pragma unroll
        for (int j4 = 0; j4 < (i + 3) / 4; ++j4) { const f32x4 l = *(const LAS f32x4*)(lf + i * 272 + j4 * 16);
            a -= (f32x2v){l.x, l.y} * T2[2 * j4]; a2 -= (f32x2v){l.z, l.w} * T2[2 * j4 + 1]; }
        const float t = (a.x + a.y) + (a2.x + a2.y);
        if (i & 1) T2[i >> 1].y = t; else T2[i >> 1].x = t;
    }
    asm volatile("" ::: "memory");
    LAS unsigned char* dd = DD + lane * 2 + b * (16 * 144);
#pragma unroll
    for (int ii = 0; ii < 16; ii += 2) { const unsigned w = cvtpk(T2[ii >> 1].x, T2[ii >> 1].y); *(LAS bf16*)(dd + ii * 144) = (bf16)w; *(LAS bf16*)(dd + (ii + 1) * 144) = (bf16)(w >> 16); }
}
__device__ __forceinline__ void inv_zero_offdiag(LAS unsigned char* DD, int w, int lane) {
    const int bi = lane >> 4, bj = (bi + w) & 3; LAS unsigned char* p = DD + lane * 144 + bj * 32;
    *(LAS v4u*)p = (v4u){0u, 0u, 0u, 0u}; *(LAS v4u*)(p + 16) = (v4u){0u, 0u, 0u, 0u};
}
__device__ __forceinline__ f32x16 ltri_tile_rt(LAS unsigned char* X, LAS unsigned char* Y, int t, int lane) {
    f32x16 acc = zero16();
    const int mb = t ? 32 : 0, nb = (t == 2) ? 32 : 0;
    if (t != 2) {
#pragma unroll
        for (int ks = 0; ks < 2; ++ks) acc = MFMA32(frag_tr(Y, 144, 16 * ks, nb, lane), frag_row(X, 144, mb, ks, lane), acc);
    }
    if (t != 0) {
#pragma unroll
        for (int ks = 2; ks < 4; ++ks) acc = MFMA32(frag_tr(Y, 144, 16 * ks, nb, lane), frag_row(X, 144, mb, ks, lane), acc);
    }
    return acc;
}

namespace rk {
constexpr int P = 144, IMG = 64 * P;
constexpr int O_KKD = 0, O_RD = IMG, O_BI = 2 * IMG, O_KI = 3 * IMG, O_KET = 4 * IMG, O_BET = 5 * IMG, O_VT = 6 * IMG  , O_AKK = 7 * IMG, O_UT = 7 * IMG  ,
              O_ARB = 8 * IMG, O_ARK = 9 * IMG, O_T = 10 * IMG, O_XT = 11 * IMG, O_HT = 12 * IMG, O_LF = 13 * IMG, PLF = 272, O_GAM = O_LF + 64 * PLF, O_WTOT = O_GAM + 256, O_END = O_WTOT + 2048;
static_assert(O_END <= 143360, "rwkv chunk LDS map");
}
struct RkStep { int row0, T, h, d, n, nch; const float* sinit; float* sfin; };
__device__ __forceinline__ bool rk_unit(int u, RkStep& s, const float* state_rwkv, float* RS) {
    if (u >= 4608) return false;
    if (u < 512) { const int bl = u >> 7, rem = u & 127; s.h = rem >> 1; s.d = rem & 1; s.row0 = MC + bl * 1024; s.T = 1024; s.nch = 16; s.sinit = state_rwkv + ((size_t)(bl * 2 + s.d) * 64 + s.h) * 4096; s.sfin = nullptr; }
    else { const int ct = u - 512, b = ct >> 7, rem = ct & 127; s.h = rem >> 1; s.d = rem & 1; s.row0 = b * 256; s.T = 256; s.nch = 4; s.sinit = nullptr; s.sfin = RS + ((size_t)(b * 2 + s.d) * 64 + s.h) * 4096; }
    s.n = 0; return true;
}
__device__ __forceinline__ int rk_row(const RkStep& s, int tau) { const int tt = s.n * 64 + tau; return s.row0 + (s.d ? (s.T - 1 - tt) : tt); }

__device__ __forceinline__ void rwkv_chunk_phase(LAS unsigned char* lds, int tid, int lane, int wave, int bx, int G, const bf16* RKVZ, const bf16* LWIC, const float* k_k, const float* k_a,
                                                 const float* state_rwkv, float* RS, bf16* YF, bf16* YB,
                                                 const float* gw_in, const float* gw_ab, const float* gw_out, bf16* WIN1, bf16* GOUT1) {
    using namespace rk;
    RkStep st;
    int u = bx;
    bool have = rk_unit(u, st, state_rwkv, RS);
    v4u qr, qk, qv, qw, qi; qr = qk = qv = qw = qi = (v4u){0u, 0u, 0u, 0u};
    if (have) { const size_t o = (size_t)rk_row(st, 8 * wave + (lane >> 3)) * D + st.h * 64 + (lane & 7) * 8;
        qr = *(const v4u*)(RKVZ + o); qk = *(const v4u*)(RKVZ + (size_t)M * D + o); qv = *(const v4u*)(RKVZ + (size_t)2 * M * D + o); qw = *(const v4u*)(LWIC + (size_t)st.d * M * D + o); qi = *(const v4u*)(LWIC + (size_t)(2 + st.d) * M * D + o); }
    f32x16 hacc = zero16();
    const int tb = (wave & 3) >> 1, vb = wave & 1;
    const int lane_in = lane; float kkc = 0.f, kac = 0.f; f32x4 kk8a = (f32x4){0.f, 0.f, 0.f, 0.f}, kk8b = kk8a;
    float tv[32]; bf16* tdst = nullptr; bool tpend = false; int tslot = 0;
#define TR_ITEMS 161
#define TR_FINISH() do { if (tpend) { _Pragma("unroll") for (int k_ = 0; k_ < 32; ++k_) asm volatile("" : "+v"(tv[k_])); \
        _Pragma("unroll") for (int q_ = 0; q_ < 4; ++q_) { v4u w_; w_.x = cvtpk(tv[8 * q_], tv[8 * q_ + 1]); w_.y = cvtpk(tv[8 * q_ + 2], tv[8 * q_ + 3]); w_.z = cvtpk(tv[8 * q_ + 4], tv[8 * q_ + 5]); w_.w = cvtpk(tv[8 * q_ + 6], tv[8 * q_ + 7]); *(v4u*)(tdst + 8 * q_) = w_; } \
        tpend = false; } } while (0)
#define TR_START() do { const int slot_ = tslot * 2 + (wave >> 2); ++tslot; if (slot_ < TR_ITEMS) { const int item_ = bx * TR_ITEMS + slot_, nb_ = item_ >> 7, k0_ = (item_ & 127) * 32; const float* src_; int ns_; \
        if (nb_ < 256) { src_ = gw_in + (size_t)k0_ * 16384 + nb_ * 64 + lane_in; ns_ = 16384; tdst = WIN1 + (size_t)(nb_ * 64 + lane_in) * 4096 + k0_; } \
        else if (nb_ < 258) { src_ = gw_ab + (size_t)k0_ * 128 + (nb_ - 256) * 64 + lane_in; ns_ = 128; tdst = WIN1 + (size_t)(16384 + (nb_ - 256) * 64 + lane_in) * 4096 + k0_; } \
        else { src_ = gw_out + (size_t)k0_ * 4096 + (nb_ - 258) * 64 + lane_in; ns_ = 4096; tdst = GOUT1 + (size_t)((nb_ - 258) * 64 + lane_in) * 4096 + k0_; } \
        _Pragma("unroll") for (int k_ = 0; k_ < 32; ++k_) tv[k_] = __builtin_nontemporal_load(src_ + (size_t)k_ * ns_); tpend = true; } } while (0)
    while (have) {
        int lane = lane_in; asm volatile("" : "+v"(lane));
        const int hh = lane >> 5, l31 = lane & 31;
        if (st.n == 0) { const int c = st.h * 64 + lane; kkc = k_k[c]; kac = k_a[c]; const float* kp = k_k + st.h * 64 + (lane & 7) * 8; kk8a = *(const f32x4*)kp; kk8b = *(const f32x4*)(kp + 4); }
        if (st.n == 0 && wave >= 4) {
            if (st.sinit) {
#pragma unroll
                for (int g = 0; g < 4; ++g) { const f32x4 v = *(const f32x4*)(st.sinit + (size_t)(vb * 32 + l31) * 64 + tb * 32 + 8 * g + 4 * hh); hacc[4 * g] = v.x; hacc[4 * g + 1] = v.y; hacc[4 * g + 2] = v.z; hacc[4 * g + 3] = v.w; }
            } else hacc = zero16();
            store_tile_T(lds + O_HT, P, vb * 32, tb * 32, hacc, lane);
        }
        float fr[8], fk[8], fw[8], fi[8]; float nrm_tok;
        {
            asm volatile("" : "+v"(qr), "+v"(qk), "+v"(qv), "+v"(qw), "+v"(qi));
            {
                v2u h0; h0.x = qk.x; h0.y = qk.y; v2u h1; h1.x = qk.z; h1.y = qk.w;
                const f32x4 ka = bf4(h0) * kk8a, kb = bf4(h1) * kk8b; const f32x4 q_ = ka * ka + kb * kb; float s_ = (q_.x + q_.y) + (q_.z + q_.w);
#define DPPF_(x, ctrl) __builtin_bit_cast(float, __builtin_amdgcn_update_dpp(0, __builtin_bit_cast(int, (x)), (ctrl), 0xf, 0xf, false))
                s_ += DPPF_(s_, 0xB1); s_ += DPPF_(s_, 0x4E); s_ += DPPF_(s_, 0x141);
#undef DPPF_
                nrm_tok = s_;
            }
            const int ro = (8 * wave + (lane >> 3)) * P + (lane & 7) * 16;
            *(LAS v4u*)(lds + O_RD + ro) = qr; *(LAS v4u*)(lds + O_KKD + ro) = qk; *(LAS v4u*)(lds + O_BI + ro) = qw; *(LAS v4u*)(lds + O_KI + ro) = qi; *(LAS v4u*)(lds + O_VT + ro) = qv;
#pragma unroll
            for (int i = 0; i < 8; ++i) { const int a = (8 * wave + i) * P + lane * 2;
                fr[i] = bf2f(*(const LAS bf16*)(lds + O_RD + a)); fk[i] = bf2f(*(const LAS bf16*)(lds + O_KKD + a)); fw[i] = bf2f(*(const LAS bf16*)(lds + O_BI + a)); fi[i] = bf2f(*(const LAS bf16*)(lds + O_KI + a)); }
            asm volatile("" ::: "memory");
        }
        float gl[8]; { float run = 0.f;
#pragma unroll
            for (int i = 0; i < 8; ++i) { run += fw[i]; gl[i] = run; } }
        ((LAS float*)(lds + O_WTOT))[wave * 64 + lane] = gl[7];
        LDS_BAR();
        float prefix = 0.f, gtot = 0.f;
#pragma unroll
        for (int w2 = 0; w2 < 8; ++w2) { const float t = ((LAS float*)(lds + O_WTOT))[w2 * 64 + lane]; if (w2 < wave) prefix += t; gtot += t; }
        {
            float ket[8], bet[8];
            float eprev = __builtin_amdgcn_exp2f(prefix);
            const float egt = __builtin_amdgcn_exp2f(gtot); if (wave == 0) ((LAS float*)(lds + O_GAM))[lane] = egt;
            float pKK[8], pR[8], pB[8], pK[8];
#pragma unroll
            for (int i = 0; i < 8; ++i) {
                const float Gi = prefix + gl[i];
                const float kkv = fk[i] * kkc; const float nrm = __builtin_bit_cast(float, __builtin_amdgcn_readlane(__builtin_bit_cast(int, nrm_tok), 8 * i)); const float kk = kkv * __builtin_amdgcn_rsqf(nrm + 1e-6f);
                const float bb = kk * fi[i], kt = fk[i] * (1.f + (fi[i] - 1.f) * kac);
                const float eG = __builtin_amdgcn_exp2f(Gi), enG = __builtin_amdgcn_rcpf(eG), eC = egt * enG;
                pKK[i] = kk * eprev; pR[i] = fr[i] * eG; pB[i] = bb * enG; pK[i] = kt * enG;
                ket[i] = kt * eC; bet[i] = -bb * eC; eprev = eG;
            }
#pragma unroll
            for (int i = 0; i < 8; i += 2) {
                LAS unsigned char* o = lds + (8 * wave + i) * P + lane * 2; unsigned w2;
                w2 = cvtpk(pKK[i], pKK[i + 1]); *(LAS bf16*)(o + O_KKD) = (bf16)w2; *(LAS bf16*)(o + O_KKD + P) = (bf16)(w2 >> 16);
                w2 = cvtpk(pR[i], pR[i + 1]);   *(LAS bf16*)(o + O_RD) = (bf16)w2;  *(LAS bf16*)(o + O_RD + P) = (bf16)(w2 >> 16);
                w2 = cvtpk(pB[i], pB[i + 1]);   *(LAS bf16*)(o + O_BI) = (bf16)w2;  *(LAS bf16*)(o + O_BI + P) = (bf16)(w2 >> 16);
                w2 = cvtpk(pK[i], pK[i + 1]);   *(LAS bf16*)(o + O_KI) = (bf16)w2;  *(LAS bf16*)(o + O_KI + P) = (bf16)(w2 >> 16);
            }
            v4u w;
            w.x = cvtpk(ket[0], ket[1]); w.y = cvtpk(ket[2], ket[3]); w.z = cvtpk(ket[4], ket[5]); w.w = cvtpk(ket[6], ket[7]); *(LAS v4u*)(lds + O_KET + lane * P + 16 * wave) = w;
            w.x = cvtpk(bet[0], bet[1]); w.y = cvtpk(bet[2], bet[3]); w.z = cvtpk(bet[4], bet[5]); w.w = cvtpk(bet[6], bet[7]); *(LAS v4u*)(lds + O_BET + lane * P + 16 * wave) = w;
        }
        LDS_BAR();
        RkStep nx = st; bool nhave = true; int nu = u;
        if (st.n + 1 < st.nch) nx.n = st.n + 1; else { nu = u + G; nhave = rk_unit(nu, nx, state_rwkv, RS); }
        if (nhave) { const size_t o = (size_t)rk_row(nx, 8 * wave + (lane >> 3)) * D + nx.h * 64 + (lane & 7) * 8;
            qr = *(const v4u*)(RKVZ + o); qk = *(const v4u*)(RKVZ + (size_t)M * D + o); qv = *(const v4u*)(RKVZ + (size_t)2 * M * D + o); qw = *(const v4u*)(LWIC + (size_t)nx.d * M * D + o); qi = *(const v4u*)(LWIC + (size_t)(2 + nx.d) * M * D + o); }
#define RK_TILE(mat_, kind_) do { const int mat = (mat_), sb = ((kind_) == 1) ? 1 : 0, tbb = ((kind_) == 0) ? 0 : 1; \
            LAS unsigned char* srcS = lds + ((mat & 1) ? O_KI : O_BI); LAS unsigned char* srcT = lds + ((mat & 2) ? O_RD : O_KKD); \
            f32x16 acc = zero16(); \
            _Pragma("unroll") for (int ks = 0; ks < 4; ++ks) acc = MFMA32(frag_row(srcS, P, sb * 32, ks, lane), frag_row(srcT, P, tbb * 32, ks, lane), acc); \
            const int t = tbb * 32 + l31; \
            LAS unsigned char* dst = lds + (mat == 0 ? O_T   : (mat == 1 ? O_AKK : (mat == 2 ? O_ARB : O_ARK))); \
            if (sb == tbb) {                                                \
                const int dlt = l31 - 4 * hh; \
                _Pragma("unroll") for (int i = 0; i < 16; ++i) { const int ci = (i & 3) + 8 * (i >> 2); const bool keep = (mat < 2) ? (ci < dlt) : (ci <= dlt); acc[i] = keep ? (mat == 2 ? -acc[i] : acc[i]) : 0.f; } \
                if (mat == 0) {                                             \
                    _Pragma("unroll") for (int g = 0; g < 4; ++g) *(LAS f32x4*)(lds + O_LF + t * PLF + (sb * 32 + 8 * g + 4 * hh) * 4) = (f32x4){acc[4 * g], acc[4 * g + 1], acc[4 * g + 2], acc[4 * g + 3]}; \
                    _Pragma("unroll") for (int i = 0; i < 16; ++i) { const int ci = (i & 3) + 8 * (i >> 2) + 4 * hh; if ((ci >> 4) == (l31 >> 4)) acc[i] = 0.f; } \
                } \
            } else if (mat == 2) { _Pragma("unroll") for (int i = 0; i < 16; ++i) acc[i] = -acc[i]; } \
            store_tile_T(dst, P, tbb * 32, sb * 32, acc, lane); } while (0)
        RK_TILE((wave < 3) ? 0 : (wave < 6 ? 2 : 1), (wave < 6) ? (wave % 3) : (wave - 6));
        LDS_BAR();
        f32x16 yacc = zero16(), isacc = zero16();
        if (wave == 3) inv_stepA(lds + O_LF, lds + O_BI, lane);
        asm volatile("" ::: "memory");
#define RK_XTILE() do { \
            f32x16 acc = zero16(); \
_Pragma("unroll") \
            for (int ks = 0; ks < 4; ++ks) { if (ks < 2 * (tb + 1)) acc = MFMA32(frag_row(lds + O_AKK, P, tb * 32, ks, lane), frag_tr(lds + O_VT, P, 16 * ks, vb * 32, lane), acc); } \
_Pragma("unroll") \
            for (int ks = 0; ks < 4; ++ks) acc = MFMA32(frag_row(lds + O_KKD, P, tb * 32, ks, lane), frag_row(lds + O_HT, P, vb * 32, ks, lane), acc); \
            store_tile_T(lds + O_XT, P, vb * 32, tb * 32, acc, lane); } while (0)
        if (wave >= 4) RK_TILE((wave == 4) ? 1 : 3, (wave == 4) ? 2 : (wave - 5));
#define RK_YPART() do { \
            _Pragma("unroll") for (int ks = 0; ks < 4; ++ks) yacc = MFMA32(frag_row(lds + O_HT, P, vb * 32, ks, lane), frag_row(lds + O_RD, P, tb * 32, ks, lane), yacc); } while (0)
        if (wave < 3) { inv_zero_offdiag(lds + O_BI, wave + 1, lane); RK_YPART(); }
        LDS_BAR();
        if (wave == 3) RK_YPART();
        if (wave >= 4) RK_XTILE();
        if (wave < 3) { const f32x16 p_ = ltri_tile_rt(lds + O_BI, lds + O_T, wave, lane); ltri_store1(lds + O_KI, wave, p_, lane);
#pragma unroll
            for (int r = 0; r < 16; ++r) isacc[r] = ((wave != 1 && l31 == crow(r, hh)) ? 1.f : 0.f) - p_[r]; }
        LDS_BAR();
        if ((wave & 3) == 3) TR_FINISH();
        if (wave < 3) { const f32x16 p_ = ltri_tile_rt(lds + O_KI, lds + O_KI, wave, lane); ltri_store1(lds + O_LF, wave, p_, lane);
#pragma unroll
            for (int r = 0; r < 16; ++r) isacc[r] += p_[r]; }
        LDS_BAR();
        if ((wave & 3) == 3) TR_START();
        if (wave < 3) { const f32x16 p_ = ltri_tile_rt(lds + O_KI, lds + O_LF, wave, lane);
#pragma unroll
            for (int r = 0; r < 16; ++r) isacc[r] -= p_[r];
            ltri_store1(lds + O_T, wave, isacc, lane); }
        LDS_BAR();
        if (wave < 3) { const f32x16 p_ = ltri_tile_rt(lds + O_T, lds + O_BI, wave, lane); ltri_store1(lds + O_KI, wave, p_, lane); }
#undef RK_YPART
#undef RK_XTILE
#undef RK_TILE
        LDS_BAR();
        if (wave >= 4) {
            f32x16 acc = zero16();
#pragma unroll
            for (int ks = 0; ks < 4; ++ks) { if (ks < 2 * (tb + 1)) acc = MFMA32(frag_row(lds + O_KI, P, tb * 32, ks, lane), frag_row(lds + O_XT, P, vb * 32, ks, lane), acc); }
            store_tile_T(lds + O_UT, P, vb * 32, tb * 32, acc, lane);
        }
        LDS_BAR();
        if (wave < 4) {
#pragma unroll
            for (int ks = 0; ks < 4; ++ks) { if (ks < 2 * (tb + 1)) { yacc = MFMA32(frag_tr(lds + O_VT, P, 16 * ks, vb * 32, lane), frag_row(lds + O_ARK, P, tb * 32, ks, lane), yacc);
                                                                      yacc = MFMA32(frag_row(lds + O_UT, P, vb * 32, ks, lane), frag_row(lds + O_ARB, P, tb * 32, ks, lane), yacc); } }
            bf16* Yd = (st.d ? YB : YF) + (size_t)rk_row(st, tb * 32 + l31) * D + st.h * 64 + vb * 32 + 4 * hh;
#pragma unroll
            for (int g = 0; g < 4; ++g) { v2u w; w.x = cvtpk(yacc[4 * g], yacc[4 * g + 1]); w.y = cvtpk(yacc[4 * g + 2], yacc[4 * g + 3]); *(v2u*)(Yd + 8 * g) = w; }
        } else {
#pragma unroll
            for (int g = 0; g < 4; ++g) { const f32x4 gm = *(const LAS f32x4*)(lds + O_GAM + (tb * 32 + 8 * g + 4 * hh) * 4); hacc[4 * g] *= gm.x; hacc[4 * g + 1] *= gm.y; hacc[4 * g + 2] *= gm.z; hacc[4 * g + 3] *= gm.w; }
#pragma unroll
            for (int ks = 0; ks < 4; ++ks) hacc = MFMA32(frag_row(lds + O_KET, P, tb * 32, ks, lane), frag_tr(lds + O_VT, P, 16 * ks, vb * 32, lane), hacc);
#pragma unroll
            for (int ks = 0; ks < 4; ++ks) hacc = MFMA32(frag_row(lds + O_BET, P, tb * 32, ks, lane), frag_row(lds + O_UT, P, vb * 32, ks, lane), hacc);
            store_tile_T(lds + O_HT, P, vb * 32, tb * 32, hacc, lane);
            if (st.n + 1 == st.nch && st.sfin) {
#pragma unroll
                for (int g = 0; g < 4; ++g) *(f32x4*)(st.sfin + (size_t)(vb * 32 + l31) * 64 + tb * 32 + 8 * g + 4 * hh) = (f32x4){hacc[4 * g], hacc[4 * g + 1], hacc[4 * g + 2], hacc[4 * g + 3]};
            }
        }
        LDS_BAR();
        st = nx; have = nhave; u = nu;
    }
    if ((wave & 3) == 3) { TR_FINISH(); while (tslot * 2 < TR_ITEMS) { TR_START(); TR_FINISH(); } }
#undef TR_FINISH
#undef TR_START
#undef TR_ITEMS
}

namespace gd {
constexpr int P128 = 272, P64 = 144;
constexpr int O_K = 0, O_V = 17408, O_ST = 34816, O_QK = 69632, O_R1 = 78848, O_R2 = 97280, O_R3 = 115712, O_VEC = 134144, O_END = O_VEC + 1040;
constexpr int O_LOFF = O_R1, O_DD = O_R1 + 9216, O_VN = O_R1, O_Q = O_R2, O_WNEG = O_R2, O_LF = O_R3, O_NI = O_R3, O_N2I = O_R3 + 9216, O_TB = O_R3, O_TBG = O_R3 + 9216, O_VNS = O_R3, PLF = 272;
constexpr int V_GC = O_VEC, V_BETA = O_VEC + 256, V_EGC = O_VEC + 512, V_ELAST = O_VEC + 768, V_EGL = O_VEC + 1024;
static_assert(O_END <= 143360, "gdn chunk LDS map");
}
struct GdStep { int row0, T, h, d, n, nch; const float* sinit; float* sfin; };
__device__ __forceinline__ bool gd_unit(int u, GdStep& s, const float* state_gdn, float* GS) {
    if (u >= 2304) return false;
    if (u < 256) { const int bl = u >> 6, rem = u & 63; s.h = rem >> 1; s.d = rem & 1; s.row0 = MC + bl * 1024; s.T = 1024; s.nch = 16; s.sinit = state_gdn + ((size_t)(bl * 2 + s.d) * 32 + s.h) * 16384; s.sfin = nullptr; }
    else { const int ct = u - 256, b = ct >> 6, rem = ct & 63; s.h = rem >> 1; s.d = rem & 1; s.row0 = b * 256; s.T = 256; s.nch = 4; s.sinit = nullptr; s.sfin = GS + ((size_t)(b * 2 + s.d) * 32 + s.h) * 16384; }
    s.n = 0; return true;
}
__device__ __forceinline__ int gd_row(const GdStep& s, int tau) { const int tt = s.n * 64 + tau; return s.row0 + (s.d ? (s.T - 1 - tt) : tt); }

__device__ __forceinline__ void gdn_chunk_phase(LAS unsigned char* lds, int tid, int lane, int wave, int bx, int G, const bf16* QKVc, const float* GB, const float* state_gdn, float* GS, bf16* OF, bf16* OB) {
    using namespace gd;
    GdStep st; int u = bx;
    bool have = gd_unit(u, st, state_gdn, GS);
    const int lane_in = lane;
    v4u pq[2], pkk[2], pvv[2]; float pg = 0.f, pb = 0.f;
    if (have) {
#pragma unroll
        for (int e = 0; e < 2; ++e) { const int p = tid + 512 * e, r = p >> 4, ch = p & 15; const bf16* src = QKVc + (size_t)gd_row(st, r) * 12288 + st.h * 128 + ch * 8;
            pq[e] = *(const v4u*)src; pkk[e] = *(const v4u*)(src + 4096); pvv[e] = *(const v4u*)(src + 8192); }
        if (wave == 0) { const size_t o = (size_t)gd_row(st, lane) * 128 + st.d * 64 + st.h; pg = GB[o]; pb = GB[o + 32]; }
    }
    f32x16 sacc[2]; sacc[0] = zero16(); sacc[1] = zero16();
    const int ib = wave >> 2, vb = wave & 3;
    const int db = wave >> 1, vb2 = 2 * (wave & 1);
    while (have) {
        int lane = lane_in; asm volatile("" : "+v"(lane));
        const int hh = lane >> 5, l31 = lane & 31;
        if (st.n == 0) {
#pragma unroll
            for (int t = 0; t < 2; ++t) {
                if (st.sinit) {
#pragma unroll
                    for (int r = 0; r < 16; ++r) sacc[t][r] = st.sinit[(size_t)(db * 32 + crow(r, hh)) * 128 + (vb2 + t) * 32 + l31];
                } else sacc[t] = zero16();
                store_tile_T(lds + O_ST, P128, (vb2 + t) * 32, db * 32, sacc[t], lane);
            }
        }
#pragma unroll
        for (int e = 0; e < 2; ++e) { const int p = tid + 512 * e, r = p >> 4, ch = p & 15;
            *(LAS v4u*)(lds + O_Q + r * P128 + ch * 16) = pq[e]; *(LAS v4u*)(lds + O_K + r * P128 + ch * 16) = pkk[e]; *(LAS v4u*)(lds + O_V + r * P128 + ch * 16) = pvv[e]; }
        if (wave == 0) {
            const float x = wave_incl_scan_dpp(pg);
            const float glast = __builtin_bit_cast(float, __builtin_amdgcn_readlane(__builtin_bit_cast(int, x), 63));
            ((LAS float*)(lds + V_GC))[lane] = x; ((LAS float*)(lds + V_BETA))[lane] = pb; ((LAS float*)(lds + V_EGC))[lane] = __builtin_amdgcn_exp2f(x); ((LAS float*)(lds + V_ELAST))[lane] = __builtin_amdgcn_exp2f(glast - x);
            if (lane == 0) ((LAS float*)(lds + V_EGL))[0] = __builtin_amdgcn_exp2f(glast);
        }
        LDS_BAR();
        GdStep nx = st; bool nhave = true; int nu = u;
        if (st.n + 1 < st.nch) nx.n = st.n + 1; else { nu = u + G; nhave = gd_unit(nu, nx, state_gdn, GS); }
        if (nhave) {
#pragma unroll
            for (int e = 0; e < 2; ++e) { const int p = tid + 512 * e, r = p >> 4, ch = p & 15; const bf16* src = QKVc + (size_t)gd_row(nx, r) * 12288 + nx.h * 128 + ch * 8;
                pq[e] = *(const v4u*)src; pkk[e] = *(const v4u*)(src + 4096); pvv[e] = *(const v4u*)(src + 8192); }
            if (wave == 0) { const size_t o = (size_t)gd_row(nx, lane) * 128 + nx.d * 64 + nx.h; pg = GB[o]; pb = GB[o + 32]; }
        }
        {
            const int mat = wave >> 2, ib2 = (wave >> 1) & 1, jb = wave & 1;
            if (jb <= ib2) {
                f32x16 acc = zero16();
#pragma unroll
                for (int ks = 0; ks < 8; ++ks) acc = MFMA32(frag_row(lds + O_K, P128, jb * 32, ks, lane), frag_row(lds + (mat ? O_Q : O_K), P128, ib2 * 32, ks, lane), acc);
                const int i = ib2 * 32 + l31; const float gi = ((LAS float*)(lds + V_GC))[i]; const float bi = mat ? 1.f : ((LAS float*)(lds + V_BETA))[i];
                const bool diag = (jb == ib2);
                if (diag) {
#pragma unroll
                    for (int g = 0; g < 4; ++g) { const f32x4 gj = *(const LAS f32x4*)(lds + V_GC + (jb * 32 + 8 * g + 4 * hh) * 4);
#pragma unroll
                        for (int e = 0; e < 4; ++e) { const int j = jb * 32 + 8 * g + 4 * hh + e; const bool keep = mat ? (j <= i) : (j < i);
                            const float ex = __builtin_amdgcn_exp2f(gi - gj[e]); acc[4 * g + e] = keep ? acc[4 * g + e] * (ex * bi) : 0.f; } }
                } else {
#pragma unroll
                    for (int g = 0; g < 4; ++g) { const f32x4 gj = *(const LAS f32x4*)(lds + V_GC + (jb * 32 + 8 * g + 4 * hh) * 4);
#pragma unroll
                        for (int e = 0; e < 4; ++e) acc[4 * g + e] *= __builtin_amdgcn_exp2f(gi - gj[e]) * bi; }
                }
                if (mat == 0) {
                    if (diag) {
#pragma unroll
                        for (int g = 0; g < 4; ++g) *(LAS f32x4*)(lds + O_LF + i * PLF + (jb * 32 + 8 * g + 4 * hh) * 4) = (f32x4){acc[4 * g], acc[4 * g + 1], acc[4 * g + 2], acc[4 * g + 3]};
#pragma unroll
                        for (int r = 0; r < 16; ++r) { const int j = jb * 32 + crow(r, hh); if ((j >> 4) == (i >> 4)) acc[r] = 0.f; }
                    }
                    store_tile_T(lds + O_LOFF, P64, ib2 * 32, jb * 32, acc, lane);
                } else store_tile_T(lds + O_QK, P64, ib2 * 32, jb * 32, acc, lane);
            }
        }
        LDS_BAR();
        if (wave == 3) inv_stepA(lds + O_LF, lds + O_DD, lane);
        asm volatile("" ::: "memory");
        f32x16 oacc = zero16(), isacc = zero16();
#define GD_QS() do { \
        _Pragma("unroll") for (int ks = 0; ks < 8; ++ks) oacc = MFMA32(frag_row(lds + O_ST, P128, vb * 32, ks, lane), frag_row(lds + O_Q, P128, ib * 32, ks, lane), oacc); \
        { const float eg = ((LAS float*)(lds + V_EGC))[ib * 32 + l31]; _Pragma("unroll") for (int r = 0; r < 16; ++r) oacc[r] *= eg; } } while (0)
        if (wave < 3) inv_zero_offdiag(lds + O_DD, wave + 1, lane);
        if (wave != 3) GD_QS();
        LDS_BAR();
        if (wave == 3) GD_QS();
        if (wave < 3) { const f32x16 p_ = ltri_tile_rt(lds + O_DD, lds + O_LOFF, wave, lane); ltri_store1(lds + O_NI, wave, p_, lane);
#pragma unroll
            for (int r = 0; r < 16; ++r) isacc[r] = ((wave != 1 && l31 == crow(r, hh)) ? 1.f : 0.f) - p_[r]; }
        LDS_BAR();
        if (wave < 3) { const f32x16 p_ = ltri_tile_rt(lds + O_NI, lds + O_NI, wave, lane); ltri_store1(lds + O_N2I, wave, p_, lane);
#pragma unroll
            for (int r = 0; r < 16; ++r) isacc[r] += p_[r]; }
        LDS_BAR();
        if (wave < 3) { const f32x16 p_ = ltri_tile_rt(lds + O_NI, lds + O_N2I, wave, lane);
#pragma unroll
            for (int r = 0; r < 16; ++r) isacc[r] -= p_[r];
            ltri_store1(lds + O_LOFF, wave, isacc, lane); }
        LDS_BAR();
        if (wave < 3) {
            const int nb = (wave == 2) ? 32 : 0; f32x16 tb_ = ltri_tile_rt(lds + O_LOFF, lds + O_DD, wave, lane), tg_ = tb_;
#pragma unroll
            for (int g = 0; g < 4; ++g) { const f32x4 bt = *(const LAS f32x4*)(lds + V_BETA + (nb + 8 * g + 4 * hh) * 4); const f32x4 eg = *(const LAS f32x4*)(lds + V_EGC + (nb + 8 * g + 4 * hh) * 4);
#pragma unroll
                for (int e = 0; e < 4; ++e) { tb_[4 * g + e] *= bt[e]; tg_[4 * g + e] *= bt[e] * eg[e]; } }
            ltri_store1(lds + O_TB, wave, tb_, lane); ltri_store1(lds + O_TBG, wave, tg_, lane);
        }
#undef GD_QS
        LDS_BAR();
        f32x16 uacc = zero16();
#pragma unroll
        for (int ks = 0; ks < 4; ++ks) { if (ks < 2 * (ib + 1)) uacc = MFMA32(frag_row(lds + O_TB, P64, ib * 32, ks, lane), frag_tr(lds + O_V, P128, 16 * ks, vb * 32, lane), uacc); }
        {
            const int ibw = wave & 1; f32x16 acc = zero16();
#pragma unroll
            for (int ks = 0; ks < 4; ++ks) { if (ks < 2 * (ibw + 1)) acc = MFMA32(frag_tr(lds + O_K, P128, 16 * ks, db * 32, lane), frag_row(lds + O_TBG, P64, ibw * 32, ks, lane), acc); }
#pragma unroll
            for (int r = 0; r < 16; ++r) acc[r] = -acc[r];
            store_tile_T(lds + O_WNEG, P128, ibw * 32, db * 32, acc, lane);
        }
        LDS_BAR();
#pragma unroll
        for (int ks = 0; ks < 8; ++ks) uacc = MFMA32(frag_row(lds + O_WNEG, P128, ib * 32, ks, lane), frag_row(lds + O_ST, P128, vb * 32, ks, lane), uacc);
        store_tile_T(lds + O_VN, P64, vb * 32, ib * 32, uacc, lane);
#pragma unroll
        for (int g = 0; g < 4; ++g) { const f32x4 el = *(const LAS f32x4*)(lds + V_ELAST + (ib * 32 + 8 * g + 4 * hh) * 4); uacc[4 * g] *= el.x; uacc[4 * g + 1] *= el.y; uacc[4 * g + 2] *= el.z; uacc[4 * g + 3] *= el.w; }
        store_tile_T(lds + O_VNS, P64, vb * 32, ib * 32, uacc, lane);
        LDS_BAR();
#pragma unroll
        for (int ks = 0; ks < 4; ++ks) { if (ks < 2 * (ib + 1)) oacc = MFMA32(frag_row(lds + O_VN, P64, vb * 32, ks, lane), frag_row(lds + O_QK, P64, ib * 32, ks, lane), oacc); }
        { bf16* Od = (st.d ? OB : OF) + (size_t)gd_row(st, ib * 32 + l31) * D + st.h * 128 + vb * 32 + 4 * hh;
#pragma unroll
          for (int g = 0; g < 4; ++g) { v2u w; w.x = cvtpk(oacc[4 * g], oacc[4 * g + 1]); w.y = cvtpk(oacc[4 * g + 2], oacc[4 * g + 3]); *(v2u*)(Od + 8 * g) = w; } }
        {
            const float egl = ((LAS float*)(lds + V_EGL))[0];
#pragma unroll
            for (int t = 0; t < 2; ++t)
#pragma unroll
                for (int r = 0; r < 16; ++r) sacc[t][r] *= egl;
#pragma unroll
            for (int ks = 0; ks < 4; ++ks) { const bf16x8 ka = frag_tr(lds + O_K, P128, 16 * ks, db * 32, lane);
                sacc[0] = MFMA32(ka, frag_row(lds + O_VNS, P64, vb2 * 32, ks, lane), sacc[0]); sacc[1] = MFMA32(ka, frag_row(lds + O_VNS, P64, (vb2 + 1) * 32, ks, lane), sacc[1]); }
            store_tile_T(lds + O_ST, P128, vb2 * 32, db * 32, sacc[0], lane); store_tile_T(lds + O_ST, P128, (vb2 + 1) * 32, db * 32, sacc[1], lane);
            if (st.n + 1 == st.nch && st.sfin) {
#pragma unroll
                for (int t = 0; t < 2; ++t)
#pragma unroll
                    for (int r = 0; r < 16; ++r) st.sfin[(size_t)(db * 32 + crow(r, hh)) * 128 + (vb2 + t) * 32 + l31] = sacc[t][r];
            }
        }
        LDS_BAR();
        st = nx; have = nhave; u = nu;
    }
}

struct MultiOrder {
    int G, c;
    int nA, nNA, pmStrideA, pnStrideA;
    int nB, pmBaseB, pnBaseB;
    int ntFull, ksplit;
    __device__ __forceinline__ bool next(int i, pg8::Unit& u) const {
        const int L = i * G + c; const int perA = NPAN * nNA, totA = nA * perA, perB = NPAN * ksplit;
        if (L >= totA + nB * perB) return false;
        int pm, pn, k0 = 0, nt = ntFull;
        if (L < totA) {
            const int g = L / perA; int wgid = L - g * perA;
            if (G == 256) {
                const int ii = wgid >> 8, cc = wgid & 255, xcd = cc & 7, j = cc >> 3, s = ii * 8 + xcd, ncb = nNA >> 2, grp = s / ncb, cb = s - grp * ncb;
                pm = g * pmStrideA + grp * 8 + (j & 7); pn = g * pnStrideA + cb * 4 + (j >> 3);
            } else {
            { const int nwg = perA, q = nwg / 8, r = nwg % 8, xcd = wgid % 8, off = wgid / 8; wgid = (xcd < r ? xcd * (q + 1) : r * (q + 1) + (xcd - r) * q) + off; }
            const int nig = 8 * nNA, gid = wgid / nig, fm = gid * 8, gsz = (NPAN - fm) < 8 ? (NPAN - fm) : 8;
            pm = g * pmStrideA + fm + ((wgid % nig) % gsz); pn = g * pnStrideA + (wgid % nig) / gsz;
            }
        } else {
            const int l = L - totA; const int gB = l / perB, rem = l - gB * perB, pmm = rem / ksplit, kq = rem - pmm * ksplit;
            pm = pmBaseB + gB * NPAN + pmm; pn = pnBaseB + gB; nt = ntFull / ksplit; k0 = kq * nt * 64;
        }
        u = pg8::Unit{pm, pn, k0, nt}; return true;
    }
    __device__ __forceinline__ void a_ready(const pg8::Unit&) const {}
    __device__ __forceinline__ void done(const pg8::Unit&) const {}
};

typedef pg8::f32x4 A4;
__device__ __forceinline__ float red8(float v) { v += __shfl_xor(v, 1); v += __shfl_xor(v, 2); v += __shfl_xor(v, 4); return v; }
__device__ __forceinline__ void bf8(v4u w, f32x4& lo, f32x4& hi) { v2u a; a.x = w.x; a.y = w.y; lo = bf4(a); a.x = w.z; a.y = w.w; hi = bf4(a); }
__device__ __forceinline__ v4u pk8(f32x4 lo, f32x4 hi) { v4u r; r.x = pk2(lo.x, lo.y); r.y = pk2(lo.z, lo.w); r.z = pk2(hi.x, hi.y); r.w = pk2(hi.z, hi.w); return r; }
struct EpiP2 {
    static constexpr bool PERM = true, AFTER_DRAIN = false;
    bf16* RKVZ; bf16* MID;
    __device__ __forceinline__ void operator()(const A4 (&acc)[2][2][4][2], const pg8::Unit& u, int wr, int wc, int fr, int fq) const {
        if (u.pn < 64) {
            const int row0 = u.pm * 256 + wr * 64 + fr, col0 = (u.pn & 15) * 256 + wc * 32 + 8 * fq;
#pragma unroll
            for (int ai = 0; ai < 2; ++ai)
#pragma unroll
                for (int m = 0; m < 4; ++m) { bf16* rowp = RKVZ + (size_t)(row0 + ai * 128 + m * 16) * D + col0;
#pragma unroll
                    for (int bj = 0; bj < 2; ++bj) { const A4 v0 = acc[ai][bj][m][0], v1 = acc[ai][bj][m][1]; v4u w;
                        w.x = pg8::cvt_pk_bf16(v0[0], v0[1]); w.y = pg8::cvt_pk_bf16(v0[2], v0[3]); w.z = pg8::cvt_pk_bf16(v1[0], v1[1]); w.w = pg8::cvt_pk_bf16(v1[2], v1[3]);
                        __builtin_nontemporal_store(w, (v4u*)(rowp + bj * 128)); } }
        } else {
            const int g2 = u.pn - 64;
            const int row0 = (u.pm - (4 + g2) * NPAN) * 256 + wr * 64 + fr, col0 = wc * 32 + 8 * fq;
#pragma unroll
            for (int ai = 0; ai < 2; ++ai)
#pragma unroll
                for (int m = 0; m < 4; ++m)
#pragma unroll
                    for (int bj = 0; bj < 2; ++bj) { A4 v0 = acc[ai][bj][m][0], v1 = acc[ai][bj][m][1];
                        if (g2 == 0) { for (int e = 0; e < 4; ++e) { v0[e] = 1.f - 2.f * __builtin_amdgcn_rcpf(1.f + __expf(2.f * v0[e])); v1[e] = 1.f - 2.f * __builtin_amdgcn_rcpf(1.f + __expf(2.f * v1[e])); } }
                        v4u w; w.x = pg8::cvt_pk_bf16(v0[0], v0[1]); w.y = pg8::cvt_pk_bf16(v0[2], v0[3]); w.z = pg8::cvt_pk_bf16(v1[0], v1[1]); w.w = pg8::cvt_pk_bf16(v1[2], v1[3]);
                        *(v4u*)(MID + ((size_t)(g2 * 2 + bj) * M + row0 + ai * 128 + m * 16) * 128 + col0) = w; }
        }
    }
};
struct EpiP3 {
    static constexpr bool PERM = true, AFTER_DRAIN = false;
    bf16* LWIC; const float* w0; const float* a0;
    __device__ __forceinline__ void operator()(const A4 (&acc)[2][2][4][2], const pg8::Unit& u, int wr, int wc, int fr, int fq) const {
        const int gi = u.pn >> 4;
        const int row0 = u.pm * 256 + wr * 64 + fr, col0 = (u.pn & 15) * 256 + wc * 32 + 8 * fq;
        const float* bias = (gi < 2 ? w0 + gi * D : a0 + (gi - 2) * D) + col0; const float osc = gi < 2 ? -0.8750387749145276f : 1.f;
        A4 bv[2][2];
#pragma unroll
        for (int bj = 0; bj < 2; ++bj)
#pragma unroll
            for (int n = 0; n < 2; ++n) bv[bj][n] = *(const A4*)(bias + bj * 128 + 4 * n);
#pragma unroll
        for (int ai = 0; ai < 2; ++ai)
#pragma unroll
            for (int m = 0; m < 4; ++m) { bf16* rowp = LWIC + (size_t)(row0 + ai * 128 + m * 16) * D + col0;
#pragma unroll
                for (int bj = 0; bj < 2; ++bj) { A4 v0 = acc[ai][bj][m][0] + bv[bj][0], v1 = acc[ai][bj][m][1] + bv[bj][1];
                    for (int e = 0; e < 4; ++e) { v0[e] = osc * sigmoidf_(v0[e]); v1[e] = osc * sigmoidf_(v1[e]); }
                    v4u w; w.x = pg8::cvt_pk_bf16(v0[0], v0[1]); w.y = pg8::cvt_pk_bf16(v0[2], v0[3]); w.z = pg8::cvt_pk_bf16(v1[0], v1[1]); w.w = pg8::cvt_pk_bf16(v1[2], v1[3]);
                    *(v4u*)(rowp + bj * 128) = w; asm volatile("" ::: "memory"); }
                }
    }
};
template <bool SRC_BF16, bool OUT_BF16>
struct EpiRes {
    static constexpr bool PERM = true, AFTER_DRAIN = false;
    const void* srcC; const void* srcL;
    void* out; const float* mod;
    __device__ __forceinline__ void operator()(const A4 (&acc)[2][2][4][2], const pg8::Unit& u, int wr, int wc, int fr, int fq) const {
        const int row0 = u.pm * 256 + wr * 64 + fr, col0 = u.pn * 256 + wc * 32 + 8 * fq;
        const int j = u.pm < 32 ? 0 : 1 + ((u.pm - 32) >> 2);
        const float* gate = mod + (size_t)j * 12288 + 2 * D + col0;
        const size_t srow = u.pm < 32 ? (size_t)row0 : (size_t)(row0 - MC);
        const void* sbase = u.pm < 32 ? srcC : srcL;
        A4 gv[2][2];
#pragma unroll
        for (int bj = 0; bj < 2; ++bj)
#pragma unroll
            for (int n = 0; n < 2; ++n) gv[bj][n] = *(const A4*)(gate + bj * 128 + 4 * n);
#pragma unroll
        for (int ai = 0; ai < 2; ++ai)
#pragma unroll
            for (int m = 0; m < 4; ++m) { const size_t so = (srow + ai * 128 + m * 16) * D + col0, od = (size_t)(row0 + ai * 128 + m * 16) * D + col0;
#pragma unroll
                for (int bj = 0; bj < 2; ++bj) {
                    f32x4 xa, xb;
                    if (SRC_BF16) bf8(*(const v4u*)((const bf16*)sbase + so + bj * 128), xa, xb);
                    else { xa = *(const f32x4*)((const float*)sbase + so + bj * 128); xb = *(const f32x4*)((const float*)sbase + so + bj * 128 + 4); }
                    const A4 a0 = acc[ai][bj][m][0], a1 = acc[ai][bj][m][1]; const A4 g0 = gv[bj][0], g1 = gv[bj][1];
                    const f32x4 oa = xa + (f32x4){g0[0] * a0[0], g0[1] * a0[1], g0[2] * a0[2], g0[3] * a0[3]}, ob = xb + (f32x4){g1[0] * a1[0], g1[1] * a1[1], g1[2] * a1[2], g1[3] * a1[3]};
                    if (OUT_BF16) *(v4u*)((bf16*)out + od + bj * 128) = pk8(oa, ob);
                    else { *(f32x4*)((float*)out + od + bj * 128) = oa; *(f32x4*)((float*)out + od + bj * 128 + 4) = ob; }
                } }
    }
};
struct EpiP8 {
    static constexpr bool PERM = true, AFTER_DRAIN = false;
    bf16* QKVZ; float* AB;
    __device__ __forceinline__ void operator()(const A4 (&acc)[2][2][4][2], const pg8::Unit& u, int wr, int wc, int fr, int fq) const {
        const int row0 = u.pm * 256 + wr * 64 + fr;
        if (u.pn < 64) {
            const int col0 = u.pn * 256 + wc * 32 + 8 * fq;
#pragma unroll
            for (int ai = 0; ai < 2; ++ai)
#pragma unroll
                for (int m = 0; m < 4; ++m) { bf16* rowp = QKVZ + (size_t)(row0 + ai * 128 + m * 16) * 16384 + col0;
#pragma unroll
                    for (int bj = 0; bj < 2; ++bj) { const A4 v0 = acc[ai][bj][m][0], v1 = acc[ai][bj][m][1]; v4u w;
                        w.x = pg8::cvt_pk_bf16(v0[0], v0[1]); w.y = pg8::cvt_pk_bf16(v0[2], v0[3]); w.z = pg8::cvt_pk_bf16(v1[0], v1[1]); w.w = pg8::cvt_pk_bf16(v1[2], v1[3]);
                        __builtin_nontemporal_store(w, (v4u*)(rowp + bj * 128)); } }
        } else {
            const int col0 = wc * 32 + 8 * fq; float* ABq = AB + (size_t)(u.k0 >> 10) * M * 128;
#pragma unroll
            for (int ai = 0; ai < 2; ++ai)
#pragma unroll
                for (int m = 0; m < 4; ++m) { float* rowp = ABq + (size_t)(row0 + ai * 128 + m * 16) * 128 + col0;
                    *(A4*)(rowp) = acc[ai][0][m][0]; *(A4*)(rowp + 4) = acc[ai][0][m][1]; }
        }
    }
};

__device__ __forceinline__ const float* xrow(const float* xp, const float* xs, int m) { return m < MC ? xp + (size_t)m * D : xs + (size_t)(m - MC) * D; }
__device__ __forceinline__ float red16(float v) { v += __shfl_xor(v, 1); v += __shfl_xor(v, 2); v += __shfl_xor(v, 4); v += __shfl_xor(v, 8); return v; }
__device__ __forceinline__ float red32(float v) { v = red16(v); v += __shfl_xor(v, 16); return v; }
__device__ __forceinline__ float sum4(f32x4 v) { return (v.x + v.y) + (v.z + v.w); }

__device__ __forceinline__ void p0_mod(LAS unsigned char* lds, const float* c, const float* c_ctx, const float* ada_w, const float* ada_b, float* MOD, int tid, int lane, int wave, int G) {
    LAS float* tab = (LAS float*)lds;
    LAS float* red = (LAS float*)(lds + 81920);
    for (int i = tid; i < 5 * D; i += NWAVES * 64) { const int j = i / D, k = i % D; const float cv = (j == 0) ? c_ctx[k] : c[(j - 1) * D + k]; tab[i] = siluf_(cv); }
    __syncthreads();
    for (int item = blockIdx.x; item < 192; item += G) {
        const int L = item / 96, cb = item % 96, half = lane >> 5;
        const float* W = ada_w + (size_t)L * D * 12288 + cb * 128 + (lane & 31) * 4;
        f32x4 acc[5];
#pragma unroll
        for (int j = 0; j < 5; ++j) acc[j] = (f32x4){0.f, 0.f, 0.f, 0.f};
        const int kb = wave * 512 + half;
#pragma unroll 8
        for (int kk = 0; kk < 256; ++kk) { const int k = kb + 2 * kk; const f32x4 w = __builtin_nontemporal_load((const f32x4*)(W + (size_t)k * 12288));
#pragma unroll
            for (int j = 0; j < 5; ++j) acc[j] += tab[j * D + k] * w; }
#pragma unroll
        for (int j = 0; j < 5; ++j) { acc[j].x += __shfl_xor(acc[j].x, 32); acc[j].y += __shfl_xor(acc[j].y, 32); acc[j].z += __shfl_xor(acc[j].z, 32); acc[j].w += __shfl_xor(acc[j].w, 32); }
        if (half == 0) {
#pragma unroll
            for (int j = 0; j < 5; ++j) *(LAS f32x4*)(red + (wave * 5 + j) * 128 + (lane & 31) * 4) = acc[j];
        }
        __syncthreads();
        for (int i = tid; i < 640; i += NWAVES * 64) { const int j = i / 128, col = i % 128; float s = 0.f;
#pragma unroll
            for (int w = 0; w < 8; ++w) s += red[(w * 5 + j) * 128 + col];
            const int gc = cb * 128 + col; MOD[(size_t)(L * 5 + j) * 12288 + gc] = s + ada_b[(size_t)L * 12288 + gc]; }
        __syncthreads();
    }
    __syncthreads();
}
__device__ __forceinline__ void rstd_rows(const float* xp, const float* xs, float* RSTD, int gw, int NGW, int lane) {
    for (int m = gw; m < M; m += NGW) { const f32x4* xr = (const f32x4*)xrow(xp, xs, m) + lane; float s = 0.f;
#pragma unroll
        for (int j = 0; j < 16; ++j) { const f32x4 v = xr[64 * j]; s += (v.x * v.x + v.y * v.y) + (v.z * v.z + v.w * v.w); }
        s = wave_sum(s); if (lane == 0) RSTD[m] = rsqrtf(s * (1.f / D) + 1e-6f); }
}
__device__ __forceinline__ int p1_nbr(int m, int q, int& j) {
    if (m < MC) { const int t = m & 255; j = 0; return (q < 2) ? (t > 0 ? m - 1 : -1) : (t < 255 ? m + 1 : -1); }
    const int ml = m - MC, t = ml & 1023, gc = t & 63, gr = t >> 6; j = 1 + (ml >> 10);
    return q == 0 ? (gc > 0 ? m - 1 : -1) : (q == 1 ? (gc < 63 ? m + 1 : -1) : (q == 2 ? (gr > 0 ? m - 64 : -1) : (gr < 15 ? m + 64 : -1)));
}
__device__ __forceinline__ void p1_mix(const float* xp, const float* xs, const float* RSTD, const float* mod0, const float* nw, const float* mu, bf16* XMIX, int gw, int NGW, int lane) {
    const f32x4 z4 = (f32x4){0.f, 0.f, 0.f, 0.f};
    for (int task = gw; task < 2048; task += NGW) {
        const int it = task & 7, rg = task >> 3, c = it * 512 + lane * 8, q = it >> 1, m0 = rg * 48;
        const f32x4 nwa = *(const f32x4*)(nw + c), nwb = *(const f32x4*)(nw + c + 4); f32x4 mua[6], mub[6];
#pragma unroll
        for (int p = 0; p < 6; ++p) { mua[p] = *(const f32x4*)(mu + p * D + c); mub[p] = *(const f32x4*)(mu + p * D + c + 4); }
        f32x4 XA[4], XB[4], NA[4], NB[4];
#pragma unroll
        for (int r = 0; r < 4; ++r) { const int m = m0 + r; int j; const int n = p1_nbr(m, q, j); const float* xr = xrow(xp, xs, m) + c; XA[r] = *(const f32x4*)xr; XB[r] = *(const f32x4*)(xr + 4);
            NA[r] = z4; NB[r] = z4; if (n >= 0) { const float* xn = xrow(xp, xs, n) + c; NA[r] = *(const f32x4*)xn; NB[r] = *(const f32x4*)(xn + 4); } }
#pragma unroll 1
        for (int b = 0; b < 12; ++b) {
            f32x4 PXA[4], PXB[4], PNA[4], PNB[4];
#pragma unroll
            for (int r = 0; r < 4; ++r) { PXA[r] = z4; PXB[r] = z4; PNA[r] = z4; PNB[r] = z4;
                if (b < 11) { const int m = m0 + 4 * (b + 1) + r; int j; const int n = p1_nbr(m, q, j); const float* xr = xrow(xp, xs, m) + c; PXA[r] = *(const f32x4*)xr; PXB[r] = *(const f32x4*)(xr + 4);
                    if (n >= 0) { const float* xn = xrow(xp, xs, n) + c; PNA[r] = *(const f32x4*)xn; PNB[r] = *(const f32x4*)(xn + 4); } } }
#pragma unroll
            for (int r = 0; r < 4; ++r) {
                const int m = m0 + 4 * b + r; int j; const int n = p1_nbr(m, q, j);
                const float* sh = mod0 + (size_t)j * 12288 + c; const float* sc = sh + D; const float rs = RSTD[m];
                const f32x4 aa = nwa * (1.f + *(const f32x4*)sc), ab = nwb * (1.f + *(const f32x4*)(sc + 4)), sa = *(const f32x4*)sh, sb = *(const f32x4*)(sh + 4);
                const f32x4 ha = XA[r] * rs * aa + sa, hb = XB[r] * rs * ab + sb; f32x4 hsa = z4, hsb = z4;
                if (n >= 0) { const float rn = RSTD[n]; hsa = NA[r] * rn * aa + sa; hsb = NB[r] * rn * ab + sb; }
                const f32x4 xa = hsa - ha, xb = hsb - hb;
#pragma unroll
                for (int p = 0; p < 6; ++p) *(v4u*)(XMIX + ((size_t)p * M + m) * D + c) = pk8(ha + xa * mua[p], hb + xb * mub[p]);
            }
#pragma unroll
            for (int r = 0; r < 4; ++r) { XA[r] = PXA[r]; XB[r] = PXB[r]; NA[r] = PNA[r]; NB[r] = PNB[r]; }
        }
    }
}
__device__ __forceinline__ void rwkv_seq(LAS float* wl, int lane, int row0, int T, int h, int d, const bf16* RKVZ, const bf16* LWIC, const float* k_k, const float* k_a,
                                         const float* sinit, float* sfin, float* Yd) {
    float S[64];
    if (sinit) {
#pragma unroll
        for (int k4 = 0; k4 < 16; ++k4) { const f32x4 v = *(const f32x4*)(sinit + lane * 64 + 4 * k4); S[4 * k4] = v.x; S[4 * k4 + 1] = v.y; S[4 * k4 + 2] = v.z; S[4 * k4 + 3] = v.w; }
    } else {
#pragma unroll
        for (int k = 0; k < 64; ++k) S[k] = 0.f;
    }
    const int c = h * 64 + lane; const float kkc = k_k[c], kac = k_a[c];
#pragma unroll 1
    for (int t0 = 0; t0 < T; t0 += 8) {
#pragma unroll
        for (int i = 0; i < 8; ++i) {
            const int tt = t0 + i, t = d ? (T - 1 - tt) : tt; const size_t row = (size_t)(row0 + t);
            const float rf = bf2f(RKVZ[((size_t)0 * M + row) * D + c]), kf = bf2f(RKVZ[((size_t)1 * M + row) * D + c]), vf = bf2f(RKVZ[((size_t)2 * M + row) * D + c]);
            const float lw = bf2f(LWIC[((size_t)d * M + row) * D + c]), ic = bf2f(LWIC[((size_t)(2 + d) * M + row) * D + c]);
            const float kkv = kf * kkc; const float nrm = wave_sum(kkv * kkv); const float kk = kkv * rsqrtf(nrm + 1e-6f);
            LAS float* p = wl + i * 384;
            p[lane] = __expf(lw); p[64 + lane] = kk; p[128 + lane] = kk * ic; p[192 + lane] = kf * (1.f + (ic - 1.f) * kac); p[256 + lane] = rf; p[320 + lane] = vf;
        }
        LDS_WAIT();
#pragma unroll 1
        for (int i = 0; i < 8; ++i) {
            const LAS f32x4* W4 = (const LAS f32x4*)(wl + i * 384); const LAS f32x4* KK4 = W4 + 16; const LAS f32x4* B4 = W4 + 32; const LAS f32x4* KT4 = W4 + 48; const LAS f32x4* R4 = W4 + 64;
            const float vv = wl[i * 384 + 320 + lane];
            float d0 = 0.f, d1 = 0.f, d2 = 0.f, d3 = 0.f;
#pragma unroll
            for (int k4 = 0; k4 < 16; ++k4) { const f32x4 q = KK4[k4]; d0 += S[4 * k4] * q.x; d1 += S[4 * k4 + 1] * q.y; d2 += S[4 * k4 + 2] * q.z; d3 += S[4 * k4 + 3] * q.w; }
            const float dot = (d0 + d1) + (d2 + d3);
            float y0 = 0.f, y1 = 0.f, y2 = 0.f, y3 = 0.f;
#pragma unroll
            for (int k4 = 0; k4 < 16; ++k4) { const f32x4 w4 = W4[k4], b4 = B4[k4], t4 = KT4[k4], r4 = R4[k4];
                float s;
                s = S[4 * k4] * w4.x + (vv * t4.x - dot * b4.x); S[4 * k4] = s; y0 += s * r4.x;
                s = S[4 * k4 + 1] * w4.y + (vv * t4.y - dot * b4.y); S[4 * k4 + 1] = s; y1 += s * r4.y;
                s = S[4 * k4 + 2] * w4.z + (vv * t4.z - dot * b4.z); S[4 * k4 + 2] = s; y2 += s * r4.z;
                s = S[4 * k4 + 3] * w4.w + (vv * t4.w - dot * b4.w); S[4 * k4 + 3] = s; y3 += s * r4.w; }
            const int tt = t0 + i, t = d ? (T - 1 - tt) : tt;
            Yd[(size_t)(row0 + t) * D + c] = (y0 + y1) + (y2 + y3);
        }
    }
    if (sfin) {
#pragma unroll
        for (int k4 = 0; k4 < 16; ++k4) *(f32x4*)(sfin + lane * 64 + 4 * k4) = (f32x4){S[4 * k4], S[4 * k4 + 1], S[4 * k4 + 2], S[4 * k4 + 3]};
    }
}
__device__ __forceinline__ void p5_post(const bf16* YF, const bf16* YB, const bf16* RKVZ, const bf16* LWIC, const float* ln_w, const float* ln_b, const float* k_a, const float* r_k, bf16* Gout, int gw, int NGW, int lane) {
    for (int task = gw; task < 2048; task += NGW) {
        const int it = task & 7, rg = task >> 3, c = it * 512 + lane * 8;
        const f32x4 lwa = *(const f32x4*)(ln_w + c), lwb = *(const f32x4*)(ln_w + c + 4), lba = *(const f32x4*)(ln_b + c), lbb = *(const f32x4*)(ln_b + c + 4);
        const f32x4 kaa = *(const f32x4*)(k_a + c), kab = *(const f32x4*)(k_a + c + 4), r0a = *(const f32x4*)(r_k + c), r0b = *(const f32x4*)(r_k + c + 4), r1a = *(const f32x4*)(r_k + D + c), r1b = *(const f32x4*)(r_k + D + c + 4);
        v4u cur[2][8], nxt[2][8];
#define NTL(p_) __builtin_nontemporal_load((const v4u*)(p_))
#define P5_LOAD(dst, m_) do { const size_t o_ = (size_t)(m_) * D + c; dst[0] = NTL(YF + o_); dst[1] = NTL(YB + o_); dst[2] = NTL(RKVZ + o_); dst[3] = NTL(RKVZ + (size_t)M * D + o_); \
            dst[4] = NTL(RKVZ + (size_t)2 * M * D + o_); dst[5] = NTL(RKVZ + (size_t)3 * M * D + o_); dst[6] = NTL(LWIC + (size_t)2 * M * D + o_); dst[7] = NTL(LWIC + (size_t)3 * M * D + o_); } while (0)
        P5_LOAD(cur[0], rg * 48); P5_LOAD(cur[1], rg * 48 + 1);
#pragma unroll 1
        for (int b = 0; b < 24; ++b) {
            const int mn = rg * 48 + 2 * (b + 1) < M - 1 ? rg * 48 + 2 * (b + 1) : M - 2;
            P5_LOAD(nxt[0], mn); P5_LOAD(nxt[1], mn + 1);
#pragma unroll
            for (int r = 0; r < 2; ++r) {
                const int m = rg * 48 + 2 * b + r; const size_t o = (size_t)m * D + c;
                f32x4 ya, yb, ta, tb; bf8(cur[r][0], ya, yb); bf8(cur[r][1], ta, tb); ya = ya + ta; yb = yb + tb;
                const float mean = red8(sum4(ya) + sum4(yb)) * (1.f / 64.f); const f32x4 da = ya - mean, db = yb - mean;
                const float var = red8(sum4(da * da) + sum4(db * db)) * (1.f / 64.f); const float rinv = rsqrtf(var + 64e-5f);
                const f32x4 yna = da * rinv * lwa + lba, ynb = db * rinv * lwb + lbb;
                f32x4 ra, rb, ka, kb, va, vb, za, zb, i0a, i0b, i1a, i1b;
                bf8(cur[r][2], ra, rb); bf8(cur[r][3], ka, kb); bf8(cur[r][4], va, vb); bf8(cur[r][5], za, zb); bf8(cur[r][6], i0a, i0b); bf8(cur[r][7], i1a, i1b);
                const f32x4 t0a = ka * (1.f + (i0a - 1.f) * kaa), t0b = kb * (1.f + (i0b - 1.f) * kab), t1a = ka * (1.f + (i1a - 1.f) * kaa), t1b = kb * (1.f + (i1b - 1.f) * kab);
                const float bonus = red8(sum4(ra * (t0a * r0a + t1a * r1a)) + sum4(rb * (t0b * r0b + t1b * r1b)));
                *(v4u*)(Gout + o) = pk8((yna + bonus * va) * silu4(za), (ynb + bonus * vb) * silu4(zb));
            }
#pragma unroll
            for (int r = 0; r < 2; ++r)
#pragma unroll
                for (int k = 0; k < 8; ++k) cur[r][k] = nxt[r][k];
        }
#undef P5_LOAD
#undef NTL
    }
}
__device__ __forceinline__ void p7_norm(const float* X1, const float* mod1, const float* nw, bf16* H1, int gw, int NGW, int lane) {
    for (int m = gw; m < M; m += NGW) {
        const int j = m < MC ? 0 : 1 + ((m - MC) >> 10); const float* sh = mod1 + (size_t)j * 12288; const float* sc = sh + D;
        const f32x4* xr = (const f32x4*)(X1 + (size_t)m * D) + lane; f32x4 v[16]; float s = 0.f;
#pragma unroll
        for (int jj = 0; jj < 16; ++jj) { v[jj] = xr[64 * jj]; s += sum4(v[jj] * v[jj]); }
        const float rs = rsqrtf(wave_sum(s) * (1.f / D) + 1e-6f);
#pragma unroll
        for (int jj = 0; jj < 16; ++jj) { const int c = jj * 256 + lane * 4; const f32x4 a4 = *(const f32x4*)(nw + c) * (1.f + *(const f32x4*)(sc + c));
            *(v2u*)(H1 + (size_t)m * D + c) = pk4(v[jj] * rs * a4 + *(const f32x4*)(sh + c)); }
    }
}
__device__ __forceinline__ void p9_prep(const bf16* QKVZ, const float* AB, const float* conv, const float* A_log, const float* dt_bias, bf16* QKVc, float* GB, int gw, int NGW, int lane) {
    for (int task = gw; task < 24 * 256; task += NGW) {
        const int it = task % 24, rg = task / 24, c = it * 512 + lane * 8;
        const f32x4 w0a = *(const f32x4*)(conv + c), w0b = *(const f32x4*)(conv + c + 4), w1a = *(const f32x4*)(conv + 12288 + c), w1b = *(const f32x4*)(conv + 12288 + c + 4), w2a = *(const f32x4*)(conv + 2 * 12288 + c), w2b = *(const f32x4*)(conv + 2 * 12288 + c + 4);
        const float qs = it < 8 ? 0.08838834764831845f : 1.f;
        const int m0 = rg * 48; const bf16* base = QKVZ + (size_t)(m0 - 1) * 16384 + c;
        v4u w[10];
#pragma unroll
        for (int j = 0; j < 10; ++j) { w[j] = (v4u){0u, 0u, 0u, 0u}; if (m0 - 1 + j >= 0 && m0 - 1 + j < M) w[j] = *(const v4u*)(base + (size_t)j * 16384); }
#pragma unroll 1
        for (int b = 0; b < 6; ++b) {
            v4u nx[8];
#pragma unroll
            for (int k = 0; k < 8; ++k) { const int j = 8 * b + 10 + k; nx[k] = (v4u){0u, 0u, 0u, 0u}; if (b < 5 && m0 - 1 + j < M) nx[k] = *(const v4u*)(base + (size_t)j * 16384); }
#pragma unroll
            for (int r = 0; r < 8; ++r) {
                const int m = m0 + 8 * b + r; int t, T; if (m < MC) { t = m & 255; T = 256; } else { t = (m - MC) & 1023; T = 1024; }
                f32x4 x1a, x1b, x0a, x0b, x2a, x2b; bf8(w[r + 1], x1a, x1b); bf8(w[r], x0a, x0b); bf8(w[r + 2], x2a, x2b);
                if (t == 0) { x0a = (f32x4){0.f, 0.f, 0.f, 0.f}; x0b = x0a; }
                if (t == T - 1) { x2a = (f32x4){0.f, 0.f, 0.f, 0.f}; x2b = x2a; }
                f32x4 ya = silu4(w0a * x0a + w1a * x1a + w2a * x2a), yb = silu4(w0b * x0b + w1b * x1b + w2b * x2b);
                if (it < 16) { const float ss = red16(sum4(ya * ya) + sum4(yb * yb)); const float scl = rsqrtf(ss + 1e-6f) * qs; ya = ya * scl; yb = yb * scl; }
                *(v4u*)(QKVc + (size_t)m * 12288 + c) = pk8(ya, yb);
            }
            w[0] = w[8]; w[1] = w[9];
#pragma unroll
            for (int k = 0; k < 8; ++k) w[2 + k] = nx[k];
        }
    }
    for (int m = gw; m < M; m += NGW) {
        const int dir = lane >> 5, hh = lane & 31; float a = 0.f, b = 0.f;
#pragma unroll
        for (int kq = 0; kq < 4; ++kq) { a += AB[((size_t)kq * M + m) * 128 + dir * 64 + hh]; b += AB[((size_t)kq * M + m) * 128 + dir * 64 + 32 + hh]; }
        GB[(size_t)m * 128 + dir * 64 + hh] = -1.4426950408889634f * __expf(A_log[dir * 32 + hh]) * softplusf_(a + dt_bias[dir * 32 + hh]);
        GB[(size_t)m * 128 + dir * 64 + 32 + hh] = sigmoidf_(b);
    }
}
__device__ __forceinline__ void gdn_seq(LAS float* wl, int lane, int row0, int T, int h, int d, int hv, const bf16* QKVc, const float* GB, const float* sinit, float* sfin, float* Od) {
    float S[128];
    const int vc = hv * 64 + lane;
    if (sinit) {
#pragma unroll
        for (int k = 0; k < 128; ++k) S[k] = sinit[k * 128 + vc];
    } else {
#pragma unroll
        for (int k = 0; k < 128; ++k) S[k] = 0.f;
    }
#pragma unroll 1
    for (int t0 = 0; t0 < T; t0 += 8) {
#pragma unroll
        for (int i = 0; i < 8; ++i) {
            const int tt = t0 + i, t = d ? (T - 1 - tt) : tt; const size_t row = (size_t)(row0 + t);
            const unsigned q2 = *(const unsigned*)(QKVc + row * 12288 + h * 128 + lane * 2), k2 = *(const unsigned*)(QKVc + row * 12288 + 4096 + h * 128 + lane * 2);
            const float vf = bf2f(QKVc[row * 12288 + 8192 + h * 128 + vc]);
            LAS float* p = wl + i * 384;
            p[2 * lane] = __builtin_bit_cast(float, q2 << 16); p[2 * lane + 1] = __builtin_bit_cast(float, q2 & 0xffff0000u);
            p[128 + 2 * lane] = __builtin_bit_cast(float, k2 << 16); p[128 + 2 * lane + 1] = __builtin_bit_cast(float, k2 & 0xffff0000u);
            p[256 + lane] = vf;
            if (lane == 0) { p[320] = __builtin_amdgcn_exp2f(GB[row * 128 + d * 64 + h]); p[321] = GB[row * 128 + d * 64 + 32 + h]; }
        }
        LDS_WAIT();
#pragma unroll 1
        for (int i = 0; i < 8; ++i) {
            const LAS f32x4* Q4 = (const LAS f32x4*)(wl + i * 384); const LAS f32x4* K4 = Q4 + 32;
            const float vv = wl[i * 384 + 256 + lane], a = wl[i * 384 + 320], beta = wl[i * 384 + 321];
            float d0 = 0.f, d1 = 0.f, d2 = 0.f, d3 = 0.f;
#pragma unroll
            for (int k4 = 0; k4 < 32; ++k4) { const f32x4 q = K4[k4]; d0 += S[4 * k4] * q.x; d1 += S[4 * k4 + 1] * q.y; d2 += S[4 * k4 + 2] * q.z; d3 += S[4 * k4 + 3] * q.w;
                if ((k4 & 7) == 7) asm volatile("" ::: "memory"); }
            const float dot = (d0 + d1) + (d2 + d3);
            const float cc = beta * (vv - a * dot);
            float y0 = 0.f, y1 = 0.f, y2 = 0.f, y3 = 0.f;
#pragma unroll
            for (int k4 = 0; k4 < 32; ++k4) { const f32x4 kq = K4[k4], qq = Q4[k4];
                float s;
                s = a * S[4 * k4] + cc * kq.x; S[4 * k4] = s; y0 += s * qq.x;
                s = a * S[4 * k4 + 1] + cc * kq.y; S[4 * k4 + 1] = s; y1 += s * qq.y;
                s = a * S[4 * k4 + 2] + cc * kq.z; S[4 * k4 + 2] = s; y2 += s * qq.z;
                s = a * S[4 * k4 + 3] + cc * kq.w; S[4 * k4 + 3] = s; y3 += s * qq.w;
                if ((k4 & 3) == 3) asm volatile("" ::: "memory"); }
            const int tt = t0 + i, t = d ? (T - 1 - tt) : tt;
            Od[(size_t)(row0 + t) * D + h * 128 + vc] = (y0 + y1) + (y2 + y3);
        }
    }
    if (sfin) {
#pragma unroll
        for (int k = 0; k < 128; ++k) sfin[k * 128 + vc] = S[k];
    }
}
__device__ __forceinline__ void p11_post(const bf16* OF, const bf16* OB, const bf16* QKVZ, const float* gnw, bf16* G2, int gw, int NGW, int lane) {
    for (int task = gw; task < 2048; task += NGW) {
        const int it = task & 7, rg = task >> 3, c = it * 512 + lane * 8;
        const f32x4 ga = *(const f32x4*)(gnw + (lane & 15) * 8), gb = *(const f32x4*)(gnw + (lane & 15) * 8 + 4);
#pragma unroll 4
        for (int r = 0; r < 48; ++r) {
            const int m = rg * 48 + r; const size_t o = (size_t)m * D + c;
            f32x4 ya, yb, ta, tb, za, zb; bf8(__builtin_nontemporal_load((const v4u*)(OF + o)), ya, yb); bf8(__builtin_nontemporal_load((const v4u*)(OB + o)), ta, tb); ya = ya + ta; yb = yb + tb;
            const float ms = red16(sum4(ya * ya) + sum4(yb * yb)) * (1.f / 128.f); const float rinv = rsqrtf(ms + 1e-6f);
            bf8(__builtin_nontemporal_load((const v4u*)(QKVZ + (size_t)m * 16384 + 12288 + c)), za, zb);
            *(v4u*)(G2 + o) = pk8(ya * rinv * ga * silu4(za), yb * rinv * gb * silu4(zb));
        }
    }
}
__device__ __forceinline__ void p13_final(float* Y, const float* fw, int gw, int NGW, int lane) {
    for (int m = gw; m < M; m += NGW) {
        f32x4* xr = (f32x4*)(Y + (size_t)m * D) + lane; f32x4 v[16]; float s = 0.f;
#pragma unroll
        for (int jj = 0; jj < 16; ++jj) { v[jj] = xr[64 * jj]; s += sum4(v[jj] * v[jj]); }
        const float rs = rsqrtf(wave_sum(s) * (1.f / D) + 1e-6f);
#pragma unroll
        for (int jj = 0; jj < 16; ++jj) xr[64 * jj] = v[jj] * rs * *(const f32x4*)(fw + jj * 256 + lane * 4);
    }
}

template <int MODE, bool IN_BF16 = false>
__device__ __forceinline__ void norm8_block(LAS unsigned char* lds, const float* xp, const float* xs, float* RSTD, const float* mod, const float* nw, bf16* H1, float* Yio, int bx, int G, int wave, int lane) {
    LAS float* red = (LAS float*)lds;
    const int c0 = wave * 512 + lane * 8, c1 = c0 + 4;
    f32x4 p0 = (f32x4){0.f, 0.f, 0.f, 0.f}, p1 = p0;
    if (MODE != 0) { p0 = *(const f32x4*)(nw + c0); p1 = *(const f32x4*)(nw + c1); }
    int par = 0;
    for (int grp = bx; grp < M / 8; grp += G, par ^= 1) {
        const int m0 = grp * 8;
        f32x4 v[8][2];
#pragma unroll
        for (int r = 0; r < 8; ++r) {
            if (IN_BF16) bf8(__builtin_nontemporal_load((const v4u*)((const bf16*)xp + (size_t)(m0 + r) * D + c0)), v[r][0], v[r][1]);
            else { const float* xr = (MODE == 2) ? Yio + (size_t)(m0 + r) * D : xrow(xp, xs, m0 + r); v[r][0] = *(const f32x4*)(xr + c0); v[r][1] = *(const f32x4*)(xr + c1); } }
#pragma unroll
        for (int r = 0; r < 8; ++r) { const float s = wave_sum_dpp(sum4(v[r][0] * v[r][0]) + sum4(v[r][1] * v[r][1])); if (lane == 0) red[(par * 8 + r) * 8 + wave] = s; }
        LDS_BAR();
        f32x4 a0 = p0, a1 = p1, s0 = (f32x4){0.f, 0.f, 0.f, 0.f}, s1 = s0;
        if (MODE == 1) { const int j = m0 < MC ? 0 : 1 + ((m0 - MC) >> 10); const float* sh = mod + (size_t)j * 12288; const float* sc = sh + D;
            a0 = p0 * (1.f + *(const f32x4*)(sc + c0)); a1 = p1 * (1.f + *(const f32x4*)(sc + c1)); s0 = *(const f32x4*)(sh + c0); s1 = *(const f32x4*)(sh + c1); }
#pragma unroll
        for (int r = 0; r < 8; ++r) {
            const LAS f32x4* rr = (const LAS f32x4*)(red + (par * 8 + r) * 8); const f32x4 ra = rr[0], rb = rr[1];
            const float rs = rsqrtf((sum4(ra) + sum4(rb)) * (1.f / D) + 1e-6f);
            if (MODE == 0) { if (wave == 0 && lane == 0) RSTD[m0 + r] = rs; }
            else if (MODE == 1) { bf16* o = H1 + (size_t)(m0 + r) * D; *(v4u*)(o + c0) = pk8(v[r][0] * rs * a0 + s0, v[r][1] * rs * a1 + s1); }
            else { float* o = Yio + (size_t)(m0 + r) * D; *(f32x4*)(o + c0) = v[r][0] * rs * a0; *(f32x4*)(o + c1) = v[r][1] * rs * a1; }
        }
    }
    LDS_BAR();
}

struct Args { const float* in[31]; float* out; unsigned char* ws; int ph_lo, ph_hi; };
__global__ void __launch_bounds__(NWAVES * 64, 2) mk_fwd(Args args) {
    extern __shared__ __attribute__((aligned(16))) unsigned char lds_raw[];
    LAS unsigned char* lds = (LAS unsigned char*)lds_raw;
    volatile LAS unsigned* MISC = (volatile LAS unsigned*)(lds + MISC_OFF);
    const int tid = threadIdx.x, lane = tid & 63, wave = __builtin_amdgcn_readfirstlane(tid >> 6);
    const int G = gridDim.x; const int bx = blockIdx.x;
    const int gw = bx * NWAVES + wave, NGW = G * NWAVES;
    unsigned char* ws = args.ws; float* out = args.out;
    gu32* ctl = (gu32*)(ws + WS_CTL);
    const float* x_prompt = args.in[0]; const float* x_sample = args.in[1]; const float* state_rwkv = args.in[2]; const float* state_gdn = args.in[3];
    const float* c_in = args.in[4]; const float* c_ctx = args.in[5]; const float* ada_w = args.in[6]; const float* ada_b = args.in[7];
    const float* norm_w = args.in[8]; const float* final_norm_w = args.in[9]; const float* rwkv_mu = args.in[10]; const float* rwkv_w_in = args.in[11];
    const float* rwkv_w0 = args.in[12]; const float* rwkv_w1 = args.in[13]; const float* rwkv_w2 = args.in[14]; const float* rwkv_a0 = args.in[15];
    const float* rwkv_a1 = args.in[16]; const float* rwkv_a2 = args.in[17]; const float* rwkv_k_k = args.in[18]; const float* rwkv_k_a = args.in[19];
    const float* rwkv_r_k = args.in[20]; const float* rwkv_ln_w = args.in[21]; const float* rwkv_ln_b = args.in[22]; const float* rwkv_w_out = args.in[23];
    const float* gdn_w_in = args.in[24]; const float* gdn_conv = args.in[25]; const float* gdn_w_ab = args.in[26]; const float* gdn_A_log = args.in[27];
    const float* gdn_dt_bias = args.in[28]; const float* gdn_norm_w = args.in[29]; const float* gdn_w_out = args.in[30];
    float* MOD = (float*)(ws + WS_MOD); float* RSTD = (float*)(ws + WS_RSTD); float* GB = (float*)(ws + WS_GB);
    bf16* WUP = (bf16*)(ws + WS_WUP); bf16* WIN = (bf16*)(ws + WS_WIN); bf16* WOUT = (bf16*)(ws + WS_WOUT);
    bf16* XMIX = (bf16*)(ws + WS_A); bf16* LWIC = (bf16*)(ws + WS_A); bf16* QKVZ = (bf16*)(ws + WS_A);
    bf16* RKVZ = (bf16*)(ws + WS_B); bf16* QKVc = (bf16*)(ws + WS_B); bf16* G2 = (bf16*)(ws + WS_B);
    float* YF = (float*)(ws + WS_C); float* YB = YF + (size_t)M * D;
    bf16* X1h = (bf16*)(ws + WS_A + 384 * MiB); bf16* X2h = (bf16*)(ws + WS_A + 480 * MiB);
    bf16* GOUT1 = (bf16*)(ws + WS_C + 224 * MiB);
    bf16* YFh = (bf16*)(ws + WS_C); bf16* YBh = YFh + (size_t)M * D;
    float* Y = out + O_Y; float* RS = out + O_RS; float* GS = out + O_GS;
    unsigned char* gsb = (unsigned char*)GS;
    bf16* Gb = (bf16*)(gsb + GS_G); bf16* MID = (bf16*)(gsb + GS_MID); float* AB = (float*)(ws + WS_C + 192 * MiB);

    for (int u = tid; u < (LDS_BYTES - LDSCTL_OFF) / 4; u += NWAVES * 64) ((LAS unsigned*)(lds + LDSCTL_OFF))[u] = 0u;
    __syncthreads();
    const int lo = args.ph_lo, hi = args.ph_hi;
    XcdBarrier bar; bar.bar = (unsigned*)(ctl + CW_BAR); bar.x = 0; bar.st = nullptr;
    if (hi - lo > 1) bar = xcd_barrier_post((unsigned*)(ctl + CW_BAR), MISC + 8);
#ifndef PHMASK
#define PHMASK 0xffffffffu
#endif
#define IN(k) (((PHMASK >> (k)) & 1u) && lo <= (k) && (k) < hi)
#ifndef DUPMASK
#define DUPMASK 0u
#endif
#define PH(k) if (IN(k)) for (int rep_ = 0; rep_ < ((((DUPMASK) >> (k)) & 1u) ? 2 : 1); ++rep_)
#define SEAM(k) do { if (IN(k) && IN((k) + 1)) xcd_barrier(bar); } while (0)

    PH(0) {
        p0_mod(lds, c_in, c_ctx, ada_w, ada_b, MOD, tid, lane, wave, G);
        LAS float* scr = (LAS float*)(lds + wave * 16384);
        constexpr int I_DD = 64 * 128, I_DN = 64 * 4, I_ND = 2 * 128;
        constexpr int NITEMS = 4 * I_DD + 4 * I_DN + 4 * I_ND + I_DD;
        for (int it = gw; it < NITEMS; it += NGW) {
            int r = it;
            if (r < 4 * I_DD) { const int p = r / I_DD; p0_transpose_item(rwkv_w_in + (size_t)p * D * D, D, D, WIN, p * D, scr, r % I_DD, lane); continue; } r -= 4 * I_DD;
            if (r < 2 * I_DN) { const int z = r / I_DN; p0_transpose_item(rwkv_w1 + (size_t)z * D * 128, D, 128, WIN, 16384 + z * 128, scr, r % I_DN, lane); continue; } r -= 2 * I_DN;
            if (r < 2 * I_DN) { const int z = r / I_DN; p0_transpose_item(rwkv_a1 + (size_t)z * D * 128, D, 128, WIN, 16640 + z * 128, scr, r % I_DN, lane); continue; } r -= 2 * I_DN;
            if (r < 2 * I_ND) { const int z = r / I_ND; p0_transpose_item(rwkv_w2 + (size_t)z * 128 * D, 128, D, WUP, z * D, scr, r % I_ND, lane); continue; } r -= 2 * I_ND;
            if (r < 2 * I_ND) { const int z = r / I_ND; p0_transpose_item(rwkv_a2 + (size_t)z * 128 * D, 128, D, WUP, (2 + z) * D, scr, r % I_ND, lane); continue; } r -= 2 * I_ND;
            p0_transpose_item(rwkv_w_out, D, D, WOUT, 0, scr, r, lane);
        }
        __syncthreads();
        norm8_block<0>(lds, x_prompt, x_sample, RSTD, nullptr, nullptr, nullptr, nullptr, bx, G, wave, lane);
    }
    SEAM(0);
    PH(1) p1_mix(x_prompt, x_sample, RSTD, MOD, norm_w, rwkv_mu, XMIX, gw, NGW, lane);
    SEAM(1);
    PH(2) {
        pg8::Gemm g{XMIX, WIN, 6 * M, 16896, D};
        MultiOrder S{G, bx, 4, 16, NPAN, 16, 2, 4 * NPAN, 64, 64, 1};
        EpiP2 E{RKVZ, MID};
        pg8::gemm_phase<EpiP2, MultiOrder, true, true>(lds, g, S, E);
    }
    SEAM(2);
    PH(3) {
        int k3 = 128; asm volatile("" : "+s"(k3));
        pg8::Gemm g{MID, WUP, 4 * M, 4 * D, k3};
        MultiOrder S{G, bx, 4, 16, NPAN, 16, 0, 0, 0, k3 / 64, 1};
        EpiP3 E{LWIC, rwkv_w0, rwkv_a0};
        pg8::gemm_phase<EpiP3, MultiOrder, true, true>(lds, g, S, E);
    }
    SEAM(3);
    PH(4) {
#if defined(RWKV_SEQ)
        LAS float* wl = (LAS float*)(lds + wave * 12288);
        if (wave < 2) {
            for (int lt = bx * 2 + wave; lt < 512; lt += 2 * G) { const int bl = lt >> 7, rem = lt & 127, h = rem >> 1, d = rem & 1;
                rwkv_seq(wl, lane, MC + bl * 1024, 1024, h, d, RKVZ, LWIC, rwkv_k_k, rwkv_k_a, state_rwkv + ((size_t)(bl * 2 + d) * 64 + h) * 4096, nullptr, d ? YB : YF); }
        } else {
            for (int ct = bx * 6 + wave - 2; ct < 4096; ct += 6 * G) { const int b = ct >> 7, rem = ct & 127, h = rem >> 1, d = rem & 1;
                rwkv_seq(wl, lane, b * 256, 256, h, d, RKVZ, LWIC, rwkv_k_k, rwkv_k_a, nullptr, RS + ((size_t)(b * 2 + d) * 64 + h) * 4096, d ? YB : YF); }
        }
#else
        rwkv_chunk_phase(lds, tid, lane, wave, bx, G, RKVZ, LWIC, rwkv_k_k, rwkv_k_a, state_rwkv, RS, YFh, YBh, gdn_w_in, gdn_w_ab, gdn_w_out, WIN, GOUT1);
#endif
    }
    SEAM(4);
    PH(5) p5_post(YFh, YBh, RKVZ, LWIC, rwkv_ln_w, rwkv_ln_b, rwkv_k_a, rwkv_r_k, Gb, gw, NGW, lane);
    SEAM(5);
    PH(6) {
        pg8::Gemm g{Gb, WOUT, M, D, D};
        MultiOrder S{G, bx, 1, 16, 0, 0, 0, 0, 0, 64, 1};
        EpiRes<false, true> E{x_prompt, x_sample, X1h, MOD};
        pg8::gemm_phase<EpiRes<false, true>, MultiOrder, true, true>(lds, g, S, E);
    }
    SEAM(6);
    PH(7) {
        norm8_block<1, true>(lds, (const float*)X1h, nullptr, nullptr, MOD + 5 * 12288, norm_w + D, Gb, nullptr, bx, G, wave, lane);
    }
    SEAM(7);
    PH(8) {
        pg8::Gemm g{Gb, WIN, M, 16640, D};
        MultiOrder S{G, bx, 1, 64, 0, 0, 1, 0, 64, 64, 4};
        EpiP8 E{QKVZ, AB};
        pg8::gemm_phase<EpiP8, MultiOrder, true, true>(lds, g, S, E);
    }
    SEAM(8);
    PH(9) p9_prep(QKVZ, AB, gdn_conv, gdn_A_log, gdn_dt_bias, QKVc, GB, gw, NGW, lane);
    SEAM(9);
    PH(10) {
#if defined(GDN_SEQ)
        LAS float* wl = (LAS float*)(lds + wave * 12288);
        float* OFb = YF; float* OBb = YB;
        if (wave < 2) {
            for (int lt = bx * 2 + wave; lt < 512; lt += 2 * G) { const int bl = lt >> 7, rem = lt & 127, h = rem >> 2, d = (rem >> 1) & 1, hv = rem & 1;
                gdn_seq(wl, lane, MC + bl * 1024, 1024, h, d, hv, QKVc, GB, state_gdn + ((size_t)(bl * 2 + d) * 32 + h) * 16384, nullptr, d ? OBb : OFb); }
        } else {
            for (int ct = bx * 6 + wave - 2; ct < 4096; ct += 6 * G) { const int b = ct >> 7, rem = ct & 127, h = rem >> 2, d = (rem >> 1) & 1, hv = rem & 1;
                gdn_seq(wl, lane, b * 256, 256, h, d, hv, QKVc, GB, nullptr, GS + ((size_t)(b * 2 + d) * 32 + h) * 16384, d ? OBb : OFb); }
        }
#else
        gdn_chunk_phase(lds, tid, lane, wave, bx, G, QKVc, GB, state_gdn, GS, YFh, YBh);
#endif
    }
    SEAM(10);
    PH(11) p11_post(YFh, YBh, QKVZ, gdn_norm_w, G2, gw, NGW, lane);
    SEAM(11);
    PH(12) {
        pg8::Gemm g{G2, GOUT1, M, D, D};
        MultiOrder S{G, bx, 1, 16, 0, 0, 0, 0, 0, 64, 1};
        EpiRes<true, true> E{X1h, X1h + (size_t)MC * D, X2h, MOD + 5 * 12288};
        pg8::gemm_phase<EpiRes<true, true>, MultiOrder, true, true>(lds, g, S, E);
    }
    SEAM(12);
    PH(13) norm8_block<2, true>(lds, (const float*)X2h, nullptr, nullptr, nullptr, final_norm_w, nullptr, Y, bx, G, wave, lane);
#undef IN
#undef SEAM
}

extern "C" void kernel_launch(void* const* d_in, const int* in_sizes, int n_in, void* d_out, int out_size, void* d_ws, size_t ws_size, hipStream_t stream) {
    static int grid = 0;
    if (grid == 0) {
        if (n_in != 31 || (size_t)out_size != O_END || ws_size < WS_END) { fprintf(stderr, "kernel_launch: unexpected shapes: n_in %d out %d ws %zu\n", n_in, out_size, ws_size); grid = -1; return; }
        int dev = 0, cus = 0, per_cu = 0;
        if (hipGetDevice(&dev) != hipSuccess || hipDeviceGetAttribute(&cus, hipDeviceAttributeMultiprocessorCount, dev) != hipSuccess) { grid = -1; return; }
        if (hipFuncSetAttribute((const void*)mk_fwd, hipFuncAttributeMaxDynamicSharedMemorySize, LDS_BYTES) != hipSuccess) { fprintf(stderr, "kernel_launch: hipFuncSetAttribute failed\n"); grid = -1; return; }
        if (hipOccupancyMaxActiveBlocksPerMultiprocessor(&per_cu, (const void*)mk_fwd, NWAVES * 64, LDS_BYTES) != hipSuccess || per_cu < 1) fprintf(stderr, "kernel_launch: occupancy query says %d\n", per_cu);
        (void)hipGetLastError();
        grid = cus;
    }
    if (grid < 0) return;
    if (hipMemsetAsync((char*)d_ws + WS_CTL, 0, CTL_ZERO_BYTES, stream) != hipSuccess) return;
    Args a{};
    for (int i = 0; i < 31; ++i) a.in[i] = (const float*)d_in[i];
    a.out = (float*)d_out; a.ws = (unsigned char*)d_ws;
#if MK_ONE_LAUNCH
    a.ph_lo = 0; a.ph_hi = NPH;
    hipLaunchKernelGGL(mk_fwd, dim3(grid), dim3(NWAVES * 64), LDS_BYTES, stream, a);
#else
    for (int p = 0; p < NPH; ++p) { a.ph_lo = p; a.ph_hi = p + 1; hipLaunchKernelGGL(mk_fwd, dim3(grid), dim3(NWAVES * 64), LDS_BYTES, stream, a); }
#endif
}
```
